# Optimizing an MI355X kernel written in HIP

```python
import math
import jax
import jax.numpy as jnp
from jax import lax
import numpy as np

D_MODEL = 2048
BATCH = 8
SEQ = 2048
DEPTH = 2

BRANCH_WIDTH = D_MODEL
N_BRANCH = 3
EPS = 1e-6
GMLP_CHUNK = 128
GMLP_GROUPS = 8
GMLP_GROUP_CH = BRANCH_WIDTH // GMLP_GROUPS
GLA_HEADS = 4
GLA_DK = (BRANCH_WIDTH // 2) // GLA_HEADS
GLA_DV = BRANCH_WIDTH // GLA_HEADS
GLA_RANK = 16
GLA_TAU = 16.0
GLA_CHUNK = 64
DIFF_HEADS = 8
DIFF_HEAD_DIM = BRANCH_WIDTH // (2 * DIFF_HEADS)
DIFF_V_DIM = 2 * DIFF_HEAD_DIM
ATTN_BLOCK = 128
REL_BUCKETS = 32
REL_MAX_DIST = 128
IN_SIZES = (BRANCH_WIDTH, BRANCH_WIDTH, BRANCH_WIDTH,
            GLA_HEADS * GLA_DK, GLA_HEADS * GLA_DK, GLA_HEADS * GLA_DV, BRANCH_WIDTH, 2 * GLA_RANK,
            2 * DIFF_HEADS * DIFF_HEAD_DIM, 2 * DIFF_HEADS * DIFF_HEAD_DIM, DIFF_HEADS * DIFF_V_DIM, BRANCH_WIDTH)
D_IN = sum(IN_SIZES)

kernel_name = "hybrid_gmlp_gla_diffattn_encoder"


def rms_norm(x, g):
    xf = x.astype(jnp.float32)
    y = xf * lax.rsqrt(jnp.mean(xf * xf, axis=-1, keepdims=True) + EPS)
    return (y * g.astype(jnp.float32)).astype(x.dtype)


def layer_norm(x, g, b):
    xf = x.astype(jnp.float32)
    mu = jnp.mean(xf, axis=-1, keepdims=True)
    var = jnp.mean(jnp.square(xf - mu), axis=-1, keepdims=True)
    y = (xf - mu) * lax.rsqrt(var + EPS)
    return (y * g.astype(jnp.float32) + b.astype(jnp.float32)).astype(x.dtype)


def t5_buckets(rel):
    nb = REL_BUCKETS // 2
    max_exact = nb // 2
    ret = jnp.where(rel > 0, nb, 0).astype(jnp.int32)
    n = jnp.abs(rel).astype(jnp.int32)
    nf = jnp.maximum(n, 1).astype(jnp.float32)
    large = max_exact + (jnp.log(nf / max_exact) / math.log(REL_MAX_DIST / max_exact)
                         * (nb - max_exact)).astype(jnp.int32)
    large = jnp.minimum(large, nb - 1)
    return ret + jnp.where(n < max_exact, n, large)


def gla_chunked(q, k, v, g):
    out_dtype = v.dtype
    b_, s_, h_, dk = q.shape
    dv = v.shape[-1]
    n_ch = s_ // GLA_CHUNK

    def to_chunks(t):
        return t.astype(jnp.float32).reshape(b_, n_ch, GLA_CHUNK, h_, t.shape[-1]).transpose(1, 0, 3, 2, 4)

    q, k, v, g = (to_chunks(t) for t in (q, k, v, g))
    cum = jnp.cumsum(g, axis=-2)
    ref = cum[..., GLA_CHUNK // 2 - 1:GLA_CHUNK // 2, :]
    last = cum[..., -1:, :]
    scores = jnp.einsum('nbhid,nbhjd->nbhij', q * jnp.exp(cum - ref), k * jnp.exp(ref - cum))
    lower_tri = jnp.tril(jnp.ones((GLA_CHUNK, GLA_CHUNK), dtype=bool))
    scores = jnp.where(lower_tri, scores, 0.0)
    o_intra = jnp.einsum('nbhij,nbhje->nbhie', scores, v)
    q_inter = q * jnp.exp(cum)
    k_state = k * jnp.exp(last - cum)
    chunk_decay = jnp.exp(last[..., 0, :])

    def step(state, xs):
        qn, kn, vn, dn = xs
        o = jnp.einsum('bhid,bhde->bhie', qn, state)
        state = dn[..., None] * state + jnp.einsum('bhid,bhie->bhde', kn, vn)
        return state, o

    state0 = jnp.zeros((b_, h_, dk, dv), jnp.float32)
    _, o_inter = lax.scan(step, state0, (q_inter, k_state, v, chunk_decay))
    o = (o_intra + o_inter).transpose(1, 0, 3, 2, 4).reshape(b_, s_, h_, dv)
    return o.astype(out_dtype)


def diff_attention(q, k, v, rel_bias, lam):
    b_, s_, h_, _, d = q.shape
    nb = s_ // ATTN_BLOCK
    qb = q.reshape(b_, nb, ATTN_BLOCK, h_, 2, d).transpose(1, 0, 2, 3, 4, 5)
    starts = jnp.arange(nb, dtype=jnp.int32) * ATTN_BLOCK
    k_pos = jnp.arange(s_, dtype=jnp.int32)
    scale = d ** -0.5

    def block(args):
        qblk, start = args
        q_pos = start + jnp.arange(ATTN_BLOCK, dtype=jnp.int32)
        bucket = t5_buckets(k_pos[None, :] - q_pos[:, None])
        bias = jnp.transpose(rel_bias[bucket], (2, 0, 1)).astype(jnp.float32)
        s = jnp.einsum('bqhcd,bkhcd->bhcqk', qblk, k).astype(jnp.float32) * scale + bias[None, :, None]
        p = jax.nn.softmax(s, axis=-1)
        a = p[:, :, 0] - lam * p[:, :, 1]
        return jnp.einsum('bhqk,bkhe->bqhe', a.astype(v.dtype), v)

    out = lax.map(block, (qb, starts))
    return out.transpose(1, 0, 2, 3, 4).reshape(b_, s_, h_, v.shape[-1])


def setup_inputs(seed: int = 0) -> dict:
    key = jax.random.key(seed)
    ks = jax.random.split(key, 18)
    f32 = jnp.float32
    L = DEPTH
    nrm = lambda k, shp: jax.random.normal(k, shp, f32)
    return {
        "x": nrm(ks[0], (BATCH, SEQ, D_MODEL)),
        "norm_pre": 1.0 + 0.02 * nrm(ks[1], (L, D_MODEL)),
        "w_in": nrm(ks[2], (L, D_MODEL, D_IN)) * D_MODEL ** -0.5,
        "gmlp_ln_g": 1.0 + 0.02 * nrm(ks[3], (L, BRANCH_WIDTH)),
        "gmlp_ln_b": 0.02 * nrm(ks[4], (L, BRANCH_WIDTH)),
        "gmlp_ws": nrm(ks[5], (L, GMLP_GROUPS, GMLP_CHUNK, GMLP_CHUNK)) * GMLP_CHUNK ** -0.5,
        "gmlp_bs": 1.0 + 0.1 * nrm(ks[6], (L, GMLP_GROUPS, GMLP_CHUNK)),
        "gla_wa2": nrm(ks[7], (L, 2, GLA_RANK, GLA_HEADS * GLA_DK)) * GLA_RANK ** -0.5,
        "gla_ba": 0.1 * nrm(ks[8], (L, 2, GLA_HEADS * GLA_DK)),
        "gla_norm": 1.0 + 0.02 * nrm(ks[9], (L, GLA_DV)),
        "diff_lambda": 0.1 * nrm(ks[10], (L, 4, DIFF_HEAD_DIM)),
        "diff_norm": 1.0 + 0.02 * nrm(ks[11], (L, DIFF_V_DIM)),
        "rel_bias": 0.3 * nrm(ks[12], (REL_BUCKETS, DIFF_HEADS)),
        "w_branch": nrm(ks[13], (L, N_BRANCH, BRANCH_WIDTH, D_MODEL)) * BRANCH_WIDTH ** -0.5,
        "w_merge": nrm(ks[14], (L, D_MODEL, N_BRANCH * D_MODEL)) * D_MODEL ** -0.5,
        "b_merge": 0.1 * nrm(ks[15], (L, N_BRANCH * D_MODEL)),
        "w_out": nrm(ks[16], (L, D_MODEL, D_MODEL)) * D_MODEL ** -0.5,
        "norm_post": 1.0 + 0.02 * nrm(ks[17], (L, D_MODEL)),
    }


def reference(x, norm_pre, w_in, gmlp_ln_g, gmlp_ln_b, gmlp_ws, gmlp_bs, gla_wa2, gla_ba, gla_norm,
              diff_lambda, diff_norm, rel_bias, w_branch, w_merge, b_merge, w_out, norm_post):
    B, S, _ = x.shape
    split_points = []
    acc = 0
    for size in IN_SIZES[:-1]:
        acc += size
        split_points.append(acc)
    rev = lambda t: jnp.flip(t, axis=1)

    for l in range(DEPTH):
        h = rms_norm(x, norm_pre[l])
        proj = jnp.einsum('bsd,de->bse', h, w_in[l])
        (a_u, a_v, a_z, b_q, b_k, b_v, b_z, b_lr,
         c_q, c_k, c_v, c_z) = jnp.split(proj, split_points, axis=-1)

        u = jax.nn.gelu(a_u)
        sv = layer_norm(jax.nn.gelu(a_v), gmlp_ln_g[l], gmlp_ln_b[l])
        sv = sv.reshape(B, S // GMLP_CHUNK, GMLP_CHUNK, GMLP_GROUPS, GMLP_GROUP_CH)
        sv = jnp.einsum('gpq,bnqgc->bnpgc', gmlp_ws[l], sv) + gmlp_bs[l].T[None, None, :, :, None]
        y_a = u * sv.reshape(B, S, BRANCH_WIDTH)

        q = b_q.reshape(B, S, GLA_HEADS, GLA_DK) * GLA_DK ** -0.5
        k = b_k.reshape(B, S, GLA_HEADS, GLA_DK)
        v = b_v.reshape(B, S, GLA_HEADS, GLA_DV)
        lr_f = b_lr[..., :GLA_RANK]
        lr_b = b_lr[..., GLA_RANK:]
        g_f = jax.nn.log_sigmoid((jnp.einsum('bsr,rk->bsk', lr_f, gla_wa2[l, 0]) + gla_ba[l, 0])
                                 .astype(jnp.float32)) / GLA_TAU
        g_b = jax.nn.log_sigmoid((jnp.einsum('bsr,rk->bsk', lr_b, gla_wa2[l, 1]) + gla_ba[l, 1])
                                 .astype(jnp.float32)) / GLA_TAU
        g_f = g_f.reshape(B, S, GLA_HEADS, GLA_DK)
        g_b = g_b.reshape(B, S, GLA_HEADS, GLA_DK)
        o_f = gla_chunked(q, k, v, g_f)
        o_b = rev(gla_chunked(rev(q), rev(k), rev(v), rev(g_b)))
        y_b = rms_norm(o_f + o_b, gla_norm[l]).reshape(B, S, GLA_HEADS * GLA_DV)

        lam_init = 0.8 - 0.6 * math.exp(-0.3 * l)
        lv = diff_lambda[l].astype(jnp.float32)
        lam = jnp.exp(jnp.sum(lv[0] * lv[1])) - jnp.exp(jnp.sum(lv[2] * lv[3])) + lam_init
        qc = c_q.reshape(B, S, DIFF_HEADS, 2, DIFF_HEAD_DIM)
        kc = c_k.reshape(B, S, DIFF_HEADS, 2, DIFF_HEAD_DIM)
        vc = c_v.reshape(B, S, DIFF_HEADS, DIFF_V_DIM)
        o_c = diff_attention(qc, kc, vc, rel_bias, lam)
        y_c = (rms_norm(o_c, diff_norm[l]) * (1.0 - lam_init)).reshape(B, S, DIFF_HEADS * DIFF_V_DIM)

        branches = jnp.stack([y_a * jax.nn.silu(a_z), y_b * jax.nn.silu(b_z), y_c * jax.nn.silu(c_z)], axis=2)
        proj_b = jnp.einsum('bsiw,iwd->bsid', branches, w_branch[l])
        gates = jax.nn.sigmoid(jnp.einsum('bsd,de->bse', h, w_merge[l]) + b_merge[l])
        gates = gates.reshape(B, S, N_BRANCH, D_MODEL)
        merged = jnp.sum(gates * proj_b, axis=2)
        out = jnp.einsum('bsd,de->bse', merged, w_out[l])
        x = x + rms_norm(out, norm_post[l])
    return x
```

```cpp
#include <hip/hip_runtime.h>
#include <hip/hip_cooperative_groups.h>
#include <cstdio>
#include <cstdint>
namespace cg = cooperative_groups;

#ifndef MK_ONE_LAUNCH
#define MK_ONE_LAUNCH 1
#endif

#define LAS __attribute__((address_space(3)))
typedef unsigned short bf16_t;
typedef short bf16x8 __attribute__((ext_vector_type(8)));
typedef short s16x4 __attribute__((ext_vector_type(4)));
typedef float f32x4 __attribute__((ext_vector_type(4)));
typedef float f32x2 __attribute__((ext_vector_type(2)));
typedef float f32x16 __attribute__((ext_vector_type(16)));
typedef unsigned u32x4 __attribute__((ext_vector_type(4)));
typedef unsigned u32x2 __attribute__((ext_vector_type(2)));

constexpr int MT = 16384, DM = 2048, SEQ = 2048;
constexpr int NP = 20480, LDP = 20480 + 64, N1 = 20736;
constexpr int C_AU = 0, C_AV = 2048, C_AZ = 4096, C_BQ = 6144, C_BK = 7168, C_BV = 8192, C_BZ = 10240, C_CQ = 12288, C_CK = 14336, C_CV = 16384, C_CZ = 18432;
constexpr float EPS = 1e-6f;
constexpr int NTHR = 512;
constexpr int LDS_BYTES = 147456 + 256;

constexpr size_t WS_W = 0;
constexpr size_t WS_WM = 0, WS_WB = 25165824, WS_WO = 50331648;
constexpr size_t WS_H = 84934656;
constexpr size_t WS_P = WS_H + 67108864;
constexpr size_t WS_GATE = WS_P, WS_MF = WS_P + 201326592, WS_MB = WS_P + 469762048, WS_OUTF = WS_P + 536870912;
constexpr size_t WS_LR = WS_P + (size_t)MT * LDP * 2;
constexpr size_t WS_ST = WS_LR + 2097152;
constexpr size_t WS_OG = WS_ST + 4194304;
constexpr size_t WS_OA = WS_OG + 134217728;
constexpr size_t WS_BR = WS_OA + 134217728;
constexpr size_t WS_TB = WS_BR + 201326592;
constexpr size_t WS_GQA = WS_BR + 67108864, WS_GKT = WS_BR + 134217728;
constexpr size_t WS_GSC = WS_TB + 16384, WS_GEC = WS_GSC + 16777216;
constexpr size_t WS_BAR = WS_GEC + 4194304;
constexpr size_t WS_END = WS_BAR + 16384;

struct Args {
    const float* x; const float* norm_pre; const float* w_in; const float* ln_g; const float* ln_b; const float* gws; const float* gbs;
    const float* wa2; const float* ba; const float* gla_norm; const float* dlam; const float* dnorm; const float* rel_bias;
    const float* w_branch; const float* w_merge; const float* b_merge; const float* w_out; const float* norm_post;
    float* out; unsigned char* ws; int ph_lo, ph_hi;
};

typedef __bf16 bf16x2_t __attribute__((ext_vector_type(2)));
__device__ __forceinline__ unsigned cvt_pk_bf16(float lo, float hi) { f32x2 v = {lo, hi}; bf16x2_t b = __builtin_convertvector(v, bf16x2_t); return __builtin_bit_cast(unsigned, b); }
__device__ __forceinline__ bf16_t f2bf(float f) { return (bf16_t)(cvt_pk_bf16(f, 0.f) & 0xffffu); }
__device__ __forceinline__ float bflo(unsigned u) { return __uint_as_float(u << 16); }
__device__ __forceinline__ float bfhi(unsigned u) { return __uint_as_float(u & 0xffff0000u); }
__device__ __forceinline__ float bf2f(bf16_t b) { return __uint_as_float(((unsigned)b) << 16); }
__device__ __forceinline__ float sigmoidf_(float x) { return __builtin_amdgcn_rcpf(1.f + __expf(-x)); }
__device__ __forceinline__ float siluf_(float x) { return x * sigmoidf_(x); }
__device__ __forceinline__ float gelu_tanh(float x) { const float y2 = 1.5957691216057308f * (x + 0.044715f * x * x * x); return x * sigmoidf_(y2); }
__device__ __forceinline__ float logsig(float z) { return fminf(z, 0.f) - __logf(1.f + __expf(-fabsf(z))); }
__device__ __forceinline__ float wave_sum(float v) {
#pragma unroll
    for (int o = 32; o >= 1; o >>= 1) v += __shfl_xor(v, o);
    return v;
}

namespace pg8 {
constexpr int BM = 256, BK = 64, HALF = 128, HTB = HALF * BK * 2, STAGE_BYTES = 8 * HTB, NXCD = 8, WGM = 8;
__host__ __device__ __forceinline__ int lds_byte(int r, int c) { const int st = (r >> 4) * 2 + (c >> 5), rr = r & 15, cc = c & 31, ob = rr * 64 + cc * 2; return st * 1024 + (ob ^ (((ob >> 9) & 1) << 5)); }
__host__ __device__ __forceinline__ void stage_rc(int b, int& R, int& C) { const int st = b / 1024, sb = b % 1024, swz = sb ^ (((sb >> 9) & 1) << 5); R = (st >> 1) * 16 + swz / 64; C = (st & 1) * 32 + (swz % 64) / 2; }
__host__ __device__ __forceinline__ int perm32(int rho) { const int n = rho >> 4, i = rho & 15; return 8 * (i >> 2) + 4 * n + (i & 3); }
struct Unit { int pm, pn; };
struct Gemm { const bf16_t* A; const bf16_t* Bt; int M, N, K; };
struct StaticOrder {
    int nM, nN, nwg, G, c;
    __device__ void init(int M, int N, int G_, int c_) { nM = M / BM; nN = N / BM; nwg = nM * nN; G = G_; c = c_; }
    __device__ bool next(int i, Unit& u) const {
        const long L = (long)i * G + c; if (L >= nwg) return false;
        int wgid = (int)L; { const int q = nwg / NXCD, r = nwg % NXCD, xcd = wgid % NXCD, off = wgid / NXCD; wgid = (xcd < r ? xcd * (q + 1) : r * (q + 1) + (xcd - r) * q) + off; }
        const int nig = WGM * nN, gid = wgid / nig, fm = gid * WGM, gsz = (nM - fm) < WGM ? (nM - fm) : WGM;
        u.pm = fm + ((wgid % nig) % gsz); u.pn = (wgid % nig) / gsz; return true;
    }
};

template <class Epi, bool ALIGN_EPI = true, bool SP2 = true>
__device__ __forceinline__ void gemm_phase(LAS unsigned char* lds, const Gemm g, const StaticOrder& S, const Epi& E, const int tid) {
    const int wid = __builtin_amdgcn_readfirstlane(tid >> 6), lane = tid & 63, wr = wid >> 2, wc = wid & 3, fr = lane & 15, fq = lane >> 4;
    const int K = g.K, nt = K / BK;
    unsigned voffA[2], voffB[2];
#pragma unroll
    for (int i = 0; i < 2; ++i) { int R, C; stage_rc(tid * 16 + i * 8192, R, C); const int Rb = Epi::PERM ? ((R & ~31) + perm32(R & 31)) : R;
        voffA[i] = (unsigned)(R * K + C) * 2u; voffB[i] = (unsigned)(Rb * K + C) * 2u; }
    const size_t kstep = (size_t)(BK * 2);
    const size_t hstep = (size_t)HALF * K * 2;
    const size_t tstep = 2 * hstep;
    const unsigned ldsw = (unsigned)wid * 1024u;
    const int aoff = lds_byte(wr * 64 + fr, fq * 8), boff = lds_byte(wc * 32 + fr, fq * 8);
#define PG8_SA(b, h) (((b) * 2 + (h)) * HTB)
#define PG8_SB(b, h) ((4 + (b) * 2 + (h)) * HTB)
#define PG8_STAGE(bufoff, gbase, voff) do { _Pragma("unroll") for (int _i = 0; _i < 2; ++_i) \
        __builtin_amdgcn_global_load_lds((const unsigned*)((const char*)(gbase) + (voff)[_i]), (LAS unsigned*)(lds + (bufoff) + ldsw + _i * 8192), 16, 0, 0); } while (0)
#define PG8_LDA(dst, b, h) do { _Pragma("unroll") for (int m = 0; m < 4; ++m) _Pragma("unroll") for (int k = 0; k < 2; ++k) dst[m][k] = *(const LAS bf16x8*)(lds + PG8_SA(b, h) + aoff + m * 2048 + k * 1024); } while (0)
#define PG8_LDB(dst, b, h) do { _Pragma("unroll") for (int n = 0; n < 2; ++n) _Pragma("unroll") for (int k = 0; k < 2; ++k) dst[n][k] = *(const LAS bf16x8*)(lds + PG8_SB(b, h) + boff + n * 2048 + k * 1024); } while (0)
#define PG8_MMA(ai, bj, At, Bt) do { __builtin_amdgcn_s_setprio(1); _Pragma("unroll") for (int m = 0; m < 4; ++m) _Pragma("unroll") for (int n = 0; n < 2; ++n) _Pragma("unroll") for (int k = 0; k < 2; ++k) \
        acc[ai][bj][m][n] = __builtin_amdgcn_mfma_f32_16x16x32_bf16(Bt[n][k], At[m][k], acc[ai][bj][m][n], 0, 0, 0); __builtin_amdgcn_s_setprio(0); } while (0)
#define PG8_WAIT_V(n) asm volatile("s_waitcnt vmcnt(" #n ")" ::: "memory")
#define PG8_WAIT_L(n) asm volatile("s_waitcnt lgkmcnt(" #n ")" ::: "memory")
#define PG8_BAR __builtin_amdgcn_s_barrier()
#define PG8_SCHED __builtin_amdgcn_sched_barrier(0)
    Unit cur, nxt; int ui = 0;
    if (!S.next(0, cur)) return;
    f32x4 acc[2][2][4][2];
#pragma unroll
    for (int a = 0; a < 2; ++a)
#pragma unroll
        for (int b = 0; b < 2; ++b)
#pragma unroll
            for (int m = 0; m < 4; ++m)
#pragma unroll
                for (int n = 0; n < 2; ++n) acc[a][b][m][n] = (f32x4){0.f, 0.f, 0.f, 0.f};
    bf16x8 At[4][2], B0[2][2], B1[2][2];
    const char* cA = (const char*)g.A + (size_t)cur.pm * tstep; const char* cB = (const char*)g.Bt + (size_t)cur.pn * tstep;
    if constexpr (SP2) {
        PG8_STAGE(PG8_SB(0, 0), cB, voffB); PG8_STAGE(PG8_SB(0, 1), cB + hstep, voffB); PG8_STAGE(PG8_SA(0, 0), cA, voffA); PG8_STAGE(PG8_SA(0, 1), cA + hstep, voffA);
        if (wr == 1) PG8_BAR;
        PG8_WAIT_V(2); PG8_BAR;
        PG8_STAGE(PG8_SB(1, 0), cB + kstep, voffB); PG8_STAGE(PG8_SA(1, 0), cA + kstep, voffA); PG8_STAGE(PG8_SB(1, 1), cB + hstep + kstep, voffB);
        PG8_WAIT_V(6); PG8_BAR;
    } else {
        PG8_STAGE(PG8_SB(0, 0), cB, voffB); PG8_STAGE(PG8_SA(0, 0), cA, voffA); PG8_STAGE(PG8_SB(0, 1), cB + hstep, voffB); PG8_STAGE(PG8_SA(0, 1), cA + hstep, voffA);
        if (wr == 1) PG8_BAR;
        PG8_WAIT_V(4); PG8_BAR;
        PG8_STAGE(PG8_SB(1, 0), cB + kstep, voffB); PG8_STAGE(PG8_SA(1, 0), cA + kstep, voffA); PG8_STAGE(PG8_SB(1, 1), cB + hstep + kstep, voffB);
        PG8_WAIT_V(6); PG8_BAR;
    }
    for (;;) {
        const bool has_next = S.next(ui + 1, nxt);
        const char* nA = has_next ? (const char*)g.A + (size_t)nxt.pm * tstep : cA; const char* nB = has_next ? (const char*)g.Bt + (size_t)nxt.pn * tstep : cB;
        for (int t = 0; t < nt; t += 2) {
            const bool last = (t == nt - 2);
            const char* a1 = cA + (size_t)(t + 1) * kstep;
            const char* a2 = last ? nA : cA + (size_t)(t + 2) * kstep; const char* b2 = last ? nB : cB + (size_t)(t + 2) * kstep;
            const char* a3 = a2 + kstep; const char* b3 = b2 + kstep;
            if constexpr (SP2) {
            PG8_LDB(B0, 0, 0); PG8_LDB(B1, 0, 1); PG8_SCHED; PG8_LDA(At, 0, 0); PG8_STAGE(PG8_SA(1, 1), a1 + hstep, voffA);
            PG8_WAIT_V(8); PG8_WAIT_L(0); PG8_BAR; PG8_MMA(0, 0, At, B0); PG8_MMA(0, 1, At, B1); PG8_BAR; PG8_SCHED;
            PG8_LDA(At, 0, 1); PG8_STAGE(PG8_SB(0, 0), b2, voffB); PG8_STAGE(PG8_SB(0, 1), b2 + hstep, voffB); PG8_STAGE(PG8_SA(0, 0), a2, voffA);
            PG8_WAIT_V(8); PG8_WAIT_L(0); PG8_BAR; PG8_MMA(1, 0, At, B0); PG8_MMA(1, 1, At, B1); PG8_BAR; PG8_SCHED;
            PG8_LDB(B0, 1, 0); PG8_LDB(B1, 1, 1); PG8_SCHED; PG8_LDA(At, 1, 0); PG8_STAGE(PG8_SA(0, 1), a2 + hstep, voffA);
            PG8_WAIT_V(8); PG8_WAIT_L(0); PG8_BAR; PG8_MMA(0, 0, At, B0); PG8_MMA(0, 1, At, B1); PG8_BAR; PG8_SCHED;
            PG8_LDA(At, 1, 1); PG8_STAGE(PG8_SB(1, 0), b3, voffB); PG8_STAGE(PG8_SB(1, 1), b3 + hstep, voffB); PG8_STAGE(PG8_SA(1, 0), a3, voffA);
            PG8_WAIT_V(8); PG8_WAIT_L(0); PG8_BAR; PG8_MMA(1, 0, At, B0); PG8_MMA(1, 1, At, B1); PG8_BAR; PG8_SCHED;
            } else {
            PG8_LDB(B0, 0, 0); PG8_SCHED; PG8_LDA(At, 0, 0); PG8_STAGE(PG8_SA(1, 1), a1 + hstep, voffA);
            PG8_WAIT_L(8); PG8_BAR; PG8_WAIT_L(0); PG8_MMA(0, 0, At, B0); PG8_BAR; PG8_SCHED;
            PG8_LDB(B1, 0, 1); PG8_STAGE(PG8_SB(0, 0), b2, voffB);
            PG8_BAR; PG8_WAIT_L(0); PG8_MMA(0, 1, At, B1); PG8_BAR;
            PG8_LDA(At, 0, 1); PG8_STAGE(PG8_SA(0, 0), a2, voffA);
            PG8_BAR; PG8_WAIT_L(0); PG8_MMA(1, 0, At, B0); PG8_BAR; PG8_SCHED;
            PG8_STAGE(PG8_SB(0, 1), b2 + hstep, voffB);
            PG8_WAIT_V(6); PG8_BAR; PG8_MMA(1, 1, At, B1); PG8_BAR;
            PG8_LDB(B0, 1, 0); PG8_SCHED; PG8_LDA(At, 1, 0); PG8_STAGE(PG8_SA(0, 1), a2 + hstep, voffA);
            PG8_WAIT_L(8); PG8_BAR; PG8_WAIT_L(0); PG8_MMA(0, 0, At, B0); PG8_BAR; PG8_SCHED;
            PG8_LDB(B1, 1, 1); PG8_STAGE(PG8_SB(1, 0), b3, voffB);
            PG8_BAR; PG8_WAIT_L(0); PG8_MMA(0, 1, At, B1); PG8_BAR;
            PG8_LDA(At, 1, 1); PG8_STAGE(PG8_SA(1, 0), a3, voffA);
            PG8_BAR; PG8_WAIT_L(0); PG8_MMA(1, 0, At, B0); PG8_BAR; PG8_SCHED;
            PG8_STAGE(PG8_SB(1, 1), b3 + hstep, voffB);
            PG8_WAIT_V(6); PG8_BAR; PG8_MMA(1, 1, At, B1); PG8_BAR;
            }
        }
        if constexpr (ALIGN_EPI) { if (wr == 0) PG8_BAR; }
        E(acc, cur, wr, wc, fr, fq);
        if (!has_next) break;
#pragma unroll
        for (int a = 0; a < 2; ++a)
#pragma unroll
            for (int b = 0; b < 2; ++b)
#pragma unroll
                for (int m = 0; m < 4; ++m)
#pragma unroll
                    for (int n = 0; n < 2; ++n) acc[a][b][m][n] = (f32x4){0.f, 0.f, 0.f, 0.f};
        cur = nxt; cA = nA; cB = nB; ++ui;
        if constexpr (ALIGN_EPI) { if (wr == 1) PG8_BAR; }
    }
    PG8_WAIT_V(0);
    if constexpr (!ALIGN_EPI) { if (wr == 0) PG8_BAR; }
    PG8_BAR;
#undef PG8_SA
#undef PG8_SB
#undef PG8_STAGE
#undef PG8_LDA
#undef PG8_LDB
#undef PG8_MMA
#undef PG8_WAIT_V
#undef PG8_WAIT_L
#undef PG8_BAR
#undef PG8_SCHED
}

struct EpiF32 {
    static constexpr bool PERM = false;
    float* C; int ldc;
    __device__ __forceinline__ void operator()(const f32x4 (&acc)[2][2][4][2], const Unit& u, int wr, int wc, int fr, int fq) const {
        const int row0 = u.pm * BM + wr * 64 + fr, col0 = u.pn * BM + wc * 32 + 4 * fq;
#pragma unroll
        for (int ai = 0; ai < 2; ++ai)
#pragma unroll
            for (int m = 0; m < 4; ++m) { float* rowp = C + (size_t)(row0 + ai * HALF + m * 16) * ldc + col0;
#pragma unroll
                for (int bj = 0; bj < 2; ++bj)
#pragma unroll
                    for (int n = 0; n < 2; ++n) *(f32x4*)(rowp + bj * HALF + n * 16) = acc[ai][bj][m][n]; }
    }
};
struct EpiBf16Out {
    static constexpr bool PERM = true;
    bf16_t* O; int ldc;
    __device__ __forceinline__ void operator()(const f32x4 (&acc)[2][2][4][2], const Unit& u, int wr, int wc, int fr, int fq) const {
        const int row0 = u.pm * BM + wr * 64 + fr; const int col0 = u.pn * BM + wc * 32 + 8 * fq;
#pragma unroll
        for (int ai = 0; ai < 2; ++ai)
#pragma unroll
            for (int m = 0; m < 4; ++m) { bf16_t* rowp = O + (size_t)(row0 + ai * HALF + m * 16) * ldc + col0;
#pragma unroll
                for (int bj = 0; bj < 2; ++bj) { const f32x4 v0 = acc[ai][bj][m][0], v1 = acc[ai][bj][m][1];
                    u32x4 w; w.x = cvt_pk_bf16(v0[0], v0[1]); w.y = cvt_pk_bf16(v0[2], v0[3]); w.z = cvt_pk_bf16(v1[0], v1[1]); w.w = cvt_pk_bf16(v1[2], v1[3]);
                    __builtin_nontemporal_store(w, (u32x4*)(rowp + bj * HALF)); } }
    }
};
struct Epi1 {
    static constexpr bool PERM = true;
    bf16_t* P; float* lr; float* stats;
    template <int KIND> __device__ __forceinline__ void run(const f32x4 (&acc)[2][2][4][2], const Unit& u, int wr, int wc, int fr, int fq, bool dost) const {
        const int row0 = u.pm * BM + wr * 64 + fr; const int col0 = u.pn * BM + wc * 32 + 8 * fq;
#pragma unroll
        for (int ai = 0; ai < 2; ++ai)
#pragma unroll
            for (int m = 0; m < 4; ++m) {
                const int row = row0 + ai * HALF + m * 16;
                bf16_t* rowp = P + (size_t)row * LDP + col0;
                float s = 0.f, q = 0.f;
#pragma unroll
                for (int bj = 0; bj < 2; ++bj) {
                    float v[8];
#pragma unroll
                    for (int j = 0; j < 4; ++j) { v[j] = acc[ai][bj][m][0][j]; v[4 + j] = acc[ai][bj][m][1][j]; }
#pragma unroll
                    for (int j = 0; j < 8; ++j) {
                        if (KIND == 1) v[j] = gelu_tanh(v[j]);
                        if (KIND == 2) v[j] = siluf_(v[j]);
                        if (KIND == 3) v[j] = v[j] * 0.0625f;
                    }
                    if (KIND == 1) {
#pragma unroll
                        for (int j = 0; j < 8; ++j) { s += v[j]; q += v[j] * v[j]; }
                    }
                    u32x4 w; w.x = cvt_pk_bf16(v[0], v[1]); w.y = cvt_pk_bf16(v[2], v[3]); w.z = cvt_pk_bf16(v[4], v[5]); w.w = cvt_pk_bf16(v[6], v[7]);
                    __builtin_nontemporal_store(w, (u32x4*)(rowp + bj * HALF));
                }
                if (KIND == 1) {
                    if (dost) {
                        s += __shfl_xor(s, 16); s += __shfl_xor(s, 32); q += __shfl_xor(q, 16); q += __shfl_xor(q, 32);
                        if (fq == 0) { *(f32x2*)(stats + ((size_t)row * 32 + (u.pn - 8) * 4 + wc) * 2) = (f32x2){s, q}; }
                    }
                }
            }
    }
    __device__ __forceinline__ void operator()(const f32x4 (&acc)[2][2][4][2], const Unit& u, int wr, int wc, int fr, int fq) const {
        const int pn = u.pn;
        if (pn == 80) {
            if (wc == 0) {
                const int row0 = u.pm * BM + wr * 64 + fr;
#pragma unroll
                for (int ai = 0; ai < 2; ++ai)
#pragma unroll
                    for (int m = 0; m < 4; ++m) { float* rp = lr + (size_t)(row0 + ai * HALF + m * 16) * 32 + 8 * fq;
                        *(f32x4*)(rp) = acc[ai][0][m][0]; *(f32x4*)(rp + 4) = acc[ai][0][m][1]; }
            }
            return;
        }
        if (pn < 16) run<1>(acc, u, wr, wc, fr, fq, pn >= 8);
        else if ((pn < 24) || (pn >= 40 && pn < 48) || (pn >= 72)) run<2>(acc, u, wr, wc, fr, fq, false);
        else if (pn < 28) run<3>(acc, u, wr, wc, fr, fq, false);
        else run<0>(acc, u, wr, wc, fr, fq, false);
    }
};
struct EpiGate {
    static constexpr bool PERM = true;
    bf16_t* G; const float* bias;
    __device__ __forceinline__ void operator()(const f32x4 (&acc)[2][2][4][2], const Unit& u, int wr, int wc, int fr, int fq) const {
        const int row0 = u.pm * BM + wr * 64 + fr; const int col0 = u.pn * BM + wc * 32 + 8 * fq;
        f32x4 bv[2][2];
#pragma unroll
        for (int bj = 0; bj < 2; ++bj)
#pragma unroll
            for (int n = 0; n < 2; ++n) bv[bj][n] = *(const f32x4*)(bias + col0 + bj * HALF + 4 * n);
#pragma unroll
        for (int ai = 0; ai < 2; ++ai)
#pragma unroll
            for (int m = 0; m < 4; ++m) { bf16_t* rowp = G + (size_t)(row0 + ai * HALF + m * 16) * DM + col0;
#pragma unroll
                for (int bj = 0; bj < 2; ++bj) { f32x4 v0 = acc[ai][bj][m][0] + bv[bj][0], v1 = acc[ai][bj][m][1] + bv[bj][1];
#pragma unroll
                    for (int j = 0; j < 4; ++j) { v0[j] = sigmoidf_(v0[j]); v1[j] = sigmoidf_(v1[j]); }
                    u32x4 w; w.x = cvt_pk_bf16(v0[0], v0[1]); w.y = cvt_pk_bf16(v0[2], v0[3]); w.z = cvt_pk_bf16(v1[0], v1[1]); w.w = cvt_pk_bf16(v1[2], v1[3]);
                    *(u32x4*)(rowp + bj * HALF) = w; } }
    }
};
struct EpiBranch {
    static constexpr bool PERM = true;
    const bf16_t* G; const bf16_t* mfi; bf16_t* mfo; int mode;
    __device__ __forceinline__ void operator()(const f32x4 (&acc)[2][2][4][2], const Unit& u, int wr, int wc, int fr, int fq) const {
        const int row0 = u.pm * BM + wr * 64 + fr; const int col0 = u.pn * BM + wc * 32 + 8 * fq;
#pragma unroll
        for (int ai = 0; ai < 2; ++ai)
#pragma unroll
            for (int m = 0; m < 4; ++m) { const size_t off = (size_t)(row0 + ai * HALF + m * 16) * DM + col0;
#pragma unroll
                for (int bj = 0; bj < 2; ++bj) { const size_t o2 = off + bj * HALF;
                    const u32x4 gw = *(const u32x4*)(G + o2);
                    f32x4 v0 = acc[ai][bj][m][0], v1 = acc[ai][bj][m][1];
                    v0[0] *= bflo(gw.x); v0[1] *= bfhi(gw.x); v0[2] *= bflo(gw.y); v0[3] *= bfhi(gw.y);
                    v1[0] *= bflo(gw.z); v1[1] *= bfhi(gw.z); v1[2] *= bflo(gw.w); v1[3] *= bfhi(gw.w);
                    if (mode > 0) { const u32x4 pw = *(const u32x4*)(mfi + o2);
                        v0[0] += bflo(pw.x); v0[1] += bfhi(pw.x); v0[2] += bflo(pw.y); v0[3] += bfhi(pw.y);
                        v1[0] += bflo(pw.z); v1[1] += bfhi(pw.z); v1[2] += bflo(pw.w); v1[3] += bfhi(pw.w); }
                    u32x4 w; w.x = cvt_pk_bf16(v0[0], v0[1]); w.y = cvt_pk_bf16(v0[2], v0[3]); w.z = cvt_pk_bf16(v1[0], v1[1]); w.w = cvt_pk_bf16(v1[2], v1[3]);
                    *(u32x4*)(mfo + o2) = w; } }
    }
};
}

#define LBAR() do { asm volatile("s_waitcnt lgkmcnt(0)" ::: "memory"); __builtin_amdgcn_s_barrier(); asm volatile("" ::: "memory"); } while (0)
namespace att {
constexpr int D = 128, NW = 8, QBLK = 32, KVBLK = 64;
constexpr float SCALE = 0.088388347648318440f;
constexpr float THR = 8.f;
#ifndef ATT_SDEPTH
#define ATT_SDEPTH 1
#endif
constexpr int SDEPTH = ATT_SDEPTH;
constexpr int LDQ = LDP, LDK = LDP, LDO = DM;
constexpr size_t SHM_V = KVBLK * D * 2, SHM_K = KVBLK * D * 2;
constexpr size_t TB_OFF = 2 * SHM_V + 2 * SHM_K + NW * 64 * 4;
constexpr size_t Q_OFF = TB_OFF + 2048;
#define KSWZ(row, colB) ((row) * 256 + ((colB) ^ (((row) & 7) << 4)))
#define SBAR() __builtin_amdgcn_sched_barrier(0)
__device__ __forceinline__ int crow(int r, int hi) { return (r & 3) + 8 * (r >> 2) + 4 * hi; }
__device__ __forceinline__ unsigned cvtpk(float lo, float hi) { return cvt_pk_bf16(lo, hi); }

__device__ __forceinline__ void partialSM(f32x16& p0, f32x16& p1, float& m_reg, float& mn, float& alpha) {
  constexpr float C = SCALE * 1.4426950408889634f;
  float pmax = p0[0]; for (int r = 1; r < 16; ++r) pmax = fmaxf(pmax, p0[r]); for (int r = 0; r < 16; ++r) pmax = fmaxf(pmax, p1[r]);
  { auto rr = __builtin_amdgcn_permlane32_swap(__float_as_uint(pmax), __float_as_uint(pmax), false, false);
    pmax = fmaxf(__uint_as_float(rr[0]), __uint_as_float(rr[1])); }
  if (__builtin_expect(__all(pmax - m_reg <= THR / SCALE), 1)) { mn = m_reg; alpha = 1.f; }
  else { mn = fmaxf(m_reg, pmax); alpha = __builtin_amdgcn_exp2f((m_reg - mn) * C); m_reg = mn; }
  float mnC = -mn * C;
  for (int r = 0; r < 16; ++r) p0[r] = fmaf(p0[r], C, mnC); for (int r = 0; r < 16; ++r) p1[r] = fmaf(p1[r], C, mnC);
  for (int r = 0; r < 16; ++r) p0[r] = __builtin_amdgcn_exp2f(p0[r]);
}
__device__ __forceinline__ void finishSM(f32x16& p0, f32x16& p1, float alpha, float& l_reg, bf16x8& pa0, bf16x8& pa1, bf16x8& pa2, bf16x8& pa3) {
  for (int r = 0; r < 16; ++r) p1[r] = __builtin_amdgcn_exp2f(p1[r]);
  float ps = 0; for (int r = 0; r < 16; ++r) ps += p0[r]; for (int r = 0; r < 16; ++r) ps += p1[r];
  { auto rr = __builtin_amdgcn_permlane32_swap(__float_as_uint(ps), __float_as_uint(ps), false, false);
    ps = __uint_as_float(rr[0]) + __uint_as_float(rr[1]); }
  l_reg = l_reg * alpha + ps;
#define PK4(P, BASE, OUT) do { unsigned a0 = cvtpk(P[BASE + 0], P[BASE + 1]), a1 = cvtpk(P[BASE + 2], P[BASE + 3]);   \
    unsigned b0 = cvtpk(P[BASE + 4], P[BASE + 5]), b1 = cvtpk(P[BASE + 6], P[BASE + 7]);                              \
    auto r0 = __builtin_amdgcn_permlane32_swap(a0, b0, false, false); auto r1 = __builtin_amdgcn_permlane32_swap(a1, b1, false, false); \
    u32x4 w = {r0[0], r1[0], r0[1], r1[1]}; OUT = *reinterpret_cast<bf16x8*>(&w); } while (0)
  PK4(p0, 0, pa0); PK4(p0, 8, pa1); PK4(p1, 0, pa2); PK4(p1, 8, pa3);
#undef PK4
}
__device__ __forceinline__ void qkt(f32x16& p0, f32x16& p1, const bf16_t* Ks, const char* Qs, int qrow, int r32, int hi, int relw, const float* tb_l, float cL, float cR) {
  const bool farL = (relw + 63 <= -91), farR = (relw - 31 >= 91);
  const float ini = farL ? cL : (farR ? cR : 0.f);
  for (int r = 0; r < 16; ++r) { p0[r] = ini; p1[r] = ini; }
  for (int d0 = 0; d0 < 8; ++d0) { int cb = (d0 * 16 + hi * 8) * 2;
    bf16x8 b0 = *reinterpret_cast<const bf16x8*>((const char*)Ks + KSWZ(r32, cb));
    bf16x8 b1 = *reinterpret_cast<const bf16x8*>((const char*)Ks + KSWZ(32 + r32, cb));
    const bf16x8 qv = *reinterpret_cast<const bf16x8*>(Qs + KSWZ(qrow, cb));
    p0 = __builtin_amdgcn_mfma_f32_32x32x16_bf16(b0, qv, p0, 0, 0, 0);
    p1 = __builtin_amdgcn_mfma_f32_32x32x16_bf16(b1, qv, p1, 0, 0, 0); }
  if (!(farL || farR)) {
    const int rel0 = relw - r32 + 128;
#pragma unroll
    for (int r = 0; r < 16; ++r) { int i0 = rel0 + crow(r, hi); int i1 = i0 + 32;
      i0 = min(max(i0, 0), 256); i1 = min(max(i1, 0), 256);
      p0[r] += tb_l[i0]; p1[r] += tb_l[i1]; }
  }
}
__device__ __forceinline__ int v_st(int k, int c) { const int kk = (k & ~0xC) | ((k & 4) << 1) | ((k & 8) >> 1); return ((kk >> 3) * 4 + (c >> 5)) * 512 + ((kk & 7) * 32 + (c & 31)) * 2; }
__device__ __forceinline__ int v_rd_base(int lane) { return ((lane & 3) << 3) | (((lane >> 2) & 3) << 6) | (((lane >> 4) & 1) << 5) | (((lane >> 5) & 1) << 8); }
constexpr int v_rd_off(int d0, int ks, int half) { return d0 * 512 + ks * 4096 + half * 2048; }
template <int OFF> __device__ __forceinline__ s16x4 tr_read(int vb) {
  s16x4 r; asm volatile("ds_read_b64_tr_b16 %0, %1 offset:%2" : "=&v"(r) : "v"(vb), "i"(OFF) : "memory"); return r;
}
template <int D0> __device__ __forceinline__ void pv_one(f32x16& od, int vb, bf16x8 pa0, bf16x8 pa1, bf16x8 pa2, bf16x8 pa3) {
  const s16x4 l0 = tr_read<v_rd_off(D0, 0, 0)>(vb), h0 = tr_read<v_rd_off(D0, 0, 1)>(vb), l1 = tr_read<v_rd_off(D0, 1, 0)>(vb), h1 = tr_read<v_rd_off(D0, 1, 1)>(vb);
  const s16x4 l2 = tr_read<v_rd_off(D0, 2, 0)>(vb), h2 = tr_read<v_rd_off(D0, 2, 1)>(vb), l3 = tr_read<v_rd_off(D0, 3, 0)>(vb), h3 = tr_read<v_rd_off(D0, 3, 1)>(vb);
  asm volatile("s_waitcnt lgkmcnt(0)" ::: "memory"); SBAR();
#define PK(L, H) (bf16x8){L[0], L[1], L[2], L[3], H[0], H[1], H[2], H[3]}
  od = __builtin_amdgcn_mfma_f32_32x32x16_bf16(pa0, PK(l0, h0), od, 0, 0, 0);
  od = __builtin_amdgcn_mfma_f32_32x32x16_bf16(pa1, PK(l1, h1), od, 0, 0, 0);
  od = __builtin_amdgcn_mfma_f32_32x32x16_bf16(pa2, PK(l2, h2), od, 0, 0, 0);
  od = __builtin_amdgcn_mfma_f32_32x32x16_bf16(pa3, PK(l3, h3), od, 0, 0, 0);
#undef PK
}
__device__ __forceinline__ void pv_d0(f32x16* o, int vb, bf16x8 pa0, bf16x8 pa1, bf16x8 pa2, bf16x8 pa3) {
  pv_one<0>(o[0], vb, pa0, pa1, pa2, pa3); pv_one<1>(o[1], vb, pa0, pa1, pa2, pa3); pv_one<2>(o[2], vb, pa0, pa1, pa2, pa3); pv_one<3>(o[3], vb, pa0, pa1, pa2, pa3);
}

__device__ __forceinline__ void attn_body(const bf16_t* __restrict__ Qb, const bf16_t* __restrict__ Kh, const bf16_t* __restrict__ Vh,
                                          bf16_t* __restrict__ Ob, int seq, char* lds, int q0, const float* __restrict__ tbg, const int tid) {
  const int wid = tid >> 6, lane = tid & 63, r32 = lane & 31, hi = lane >> 5;
  bf16_t* V_lds = (bf16_t*)lds; bf16_t* K_lds = (bf16_t*)(lds + 2 * SHM_V);
  float* ws = (float*)(lds + 2 * SHM_V + 2 * SHM_K) + wid * 64; float* li_l = ws; float* al_l = ws + 32;
  float* tb_l = (float*)(lds + TB_OFF);
  __syncthreads();
  if (tid < 257) tb_l[tid] = tbg[tid];
  const float cL = tbg[0], cR = tbg[256];
  const int q0w = q0 + wid * QBLK;
  float m_reg = -1e30f, l_reg = 0; f32x16 o[4] = {};
  const char* Qs = lds + Q_OFF + (wid >> 1) * 16384; const int qrow = (wid & 1) * 32 + r32;
  { const bf16_t* Qw = Qb + (long)(wid * QBLK + r32) * LDQ + hi * 8;
#pragma unroll
    for (int d0 = 0; d0 < 8; ++d0) { const bf16x8 t = *reinterpret_cast<const bf16x8*>(Qw + d0 * 16); *(bf16x8*)(const_cast<char*>(Qs) + KSWZ(qrow, (d0 * 16 + hi * 8) * 2)) = t; } }
  const int sr = tid >> 4, sc = (tid & 15) * 8, vst0 = v_st(sr, sc), vst1 = v_st(32 + sr, sc);
  const int vb0 = (int)(uintptr_t)V_lds + v_rd_base(lane);
  struct { bf16x8 vs0, vs1, ks0, ks1; } sr_[SDEPTH];
#define SLOAD(i, k0) do { sr_[i].vs0 = *(const bf16x8*)(&Vh[(long)((k0) + sr) * LDK + sc]); sr_[i].vs1 = *(const bf16x8*)(&Vh[(long)((k0) + 32 + sr) * LDK + sc]); \
    sr_[i].ks0 = *(const bf16x8*)(&Kh[(long)((k0) + sr) * LDK + sc]); sr_[i].ks1 = *(const bf16x8*)(&Kh[(long)((k0) + 32 + sr) * LDK + sc]); } while (0)
#define SWRITE(b, i) do { *(bf16x8*)((char*)V_lds + (b) * SHM_V + vst0) = sr_[i].vs0;          \
    *(bf16x8*)((char*)V_lds + (b) * SHM_V + vst1) = sr_[i].vs1; int kc = sc * 2;               \
    *(bf16x8*)((char*)K_lds + (b) * SHM_K + KSWZ(sr, kc)) = sr_[i].ks0;                       \
    *(bf16x8*)((char*)K_lds + (b) * SHM_K + KSWZ(32 + sr, kc)) = sr_[i].ks1; } while (0)
#define SWAIT() do { if constexpr (SDEPTH == 2) asm volatile("s_waitcnt vmcnt(4)" ::: "memory"); else asm volatile("s_waitcnt vmcnt(0)" ::: "memory"); } while (0)
#define RESC(a) do { if (__any((a) < 1.f)) { if (hi == 0) al_l[r32] = (a); asm volatile("s_waitcnt lgkmcnt(0)" ::: "memory"); \
    for (int d = 0; d < 4; ++d) for (int r = 0; r < 16; ++r) o[d][r] *= al_l[crow(r, hi)]; } } while (0)
  f32x16 pA0, pA1, pB0, pB1; float mnA, mnB, alA, alB; bf16x8 pa0, pa1, pa2, pa3; const int NT = seq / KVBLK;
  constexpr int SE = 0, SO = SDEPTH - 1;
  SLOAD(SE, 0); asm volatile("s_waitcnt vmcnt(0)" ::: "memory"); SWRITE(0, SE); __syncthreads();
  qkt(pA0, pA1, K_lds, Qs, qrow, r32, hi, 0 - q0w, tb_l, cL, cR); partialSM(pA0, pA1, m_reg, mnA, alA);
  SLOAD(SO, KVBLK); if constexpr (SDEPTH == 2) { if (2 < NT) SLOAD(SE, 2 * KVBLK); }
  SWAIT(); SWRITE(1, SO); __syncthreads();
  for (int j = 1; j + 1 < NT; j += 2) {
    SBAR(); qkt(pB0, pB1, (bf16_t*)((char*)K_lds + SHM_K), Qs, qrow, r32, hi, j * KVBLK - q0w, tb_l, cL, cR);
    SBAR(); SLOAD(SO, (j + SDEPTH) * KVBLK); SBAR();
    finishSM(pA0, pA1, alA, l_reg, pa0, pa1, pa2, pa3); SBAR();
    pv_d0(o, vb0, pa0, pa1, pa2, pa3); partialSM(pB0, pB1, m_reg, mnB, alB);
    LBAR(); SWAIT(); SWRITE(0, SE);
    RESC(alB); LBAR();
    SBAR(); qkt(pA0, pA1, K_lds, Qs, qrow, r32, hi, (j + 1) * KVBLK - q0w, tb_l, cL, cR);
    SBAR(); if (SDEPTH == 1 || j + 3 < NT) SLOAD(SE, (j + 1 + SDEPTH) * KVBLK); SBAR();
    finishSM(pB0, pB1, alB, l_reg, pa0, pa1, pa2, pa3); SBAR();
    pv_d0(o, vb0 + (int)SHM_V, pa0, pa1, pa2, pa3); partialSM(pA0, pA1, m_reg, mnA, alA);
    LBAR(); SWAIT(); SWRITE(1, SO);
    RESC(alA); LBAR();
  }
  SBAR(); qkt(pB0, pB1, (bf16_t*)((char*)K_lds + SHM_K), Qs, qrow, r32, hi, (NT - 1) * KVBLK - q0w, tb_l, cL, cR);
  finishSM(pA0, pA1, alA, l_reg, pa0, pa1, pa2, pa3); SBAR();
  pv_d0(o, vb0, pa0, pa1, pa2, pa3); partialSM(pB0, pB1, m_reg, mnB, alB);
  __syncthreads(); RESC(alB);
  finishSM(pB0, pB1, alB, l_reg, pa0, pa1, pa2, pa3); SBAR();
  pv_d0(o, vb0 + (int)SHM_V, pa0, pa1, pa2, pa3);
  if (hi == 0) li_l[r32] = l_reg; asm volatile("s_waitcnt lgkmcnt(0)" ::: "memory");
  float rli[16];
#pragma unroll
  for (int r = 0; r < 16; ++r) rli[r] = __builtin_amdgcn_rcpf(li_l[crow(r, hi)]);
  bf16_t* Ow = Ob + (long)(wid * QBLK) * LDO;
#pragma unroll
  for (int r = 0; r < 16; ++r) { int orow = crow(r, hi);
#pragma unroll
    for (int d0 = 0; d0 < 4; ++d0) Ow[(long)orow * LDO + d0 * 32 + r32] = f2bf(o[d0][r] * rli[r]); }
#undef SLOAD
#undef SWRITE
#undef SWAIT
#undef RESC
}
}

struct Ctx {
    Args a; char* lds; int tid, lane, wid, G, bx, vcu;
};

__device__ __forceinline__ int srccol(int nd, int mode) {
    if (mode == 0) return nd;
    return nd < 12288 ? nd : (nd < 20480 ? nd + 32 : (nd < 20512 ? nd - 20480 + 12288 : -1));
}
__device__ __forceinline__ void wconv_job(const Ctx& c, const float* __restrict__ src0, int ld, bf16_t* __restrict__ dst0, int nd, int mode, int nbatch) {
    float* tile = (float*)c.lds;
    int tz = 0; asm volatile("" : "+v"(tz));
    const int tid = c.tid + tz;
    const int ntn = nd / 256, ntb = ntn * 32, ntiles = ntb * nbatch;
    f32x4 v[8];
#define WC_LOAD(t) do { const int bi_ = (t) / ntb, tr_ = (t) - bi_ * ntb; const float* src = src0 + (size_t)bi_ * 2048 * ld; const int tn_ = tr_ % ntn, tk_ = tr_ / ntn; _Pragma("unroll") for (int it = 0; it < 8; ++it) { const int idx = it * NTHR + tid; const int kk = idx >> 6, nn4 = (idx & 63) * 4; \
        const int sc = srccol(tn_ * 256 + nn4, mode); v[it] = (f32x4){0.f, 0.f, 0.f, 0.f}; if (sc >= 0) v[it] = __builtin_nontemporal_load((const f32x4*)(src + (size_t)(tk_ * 64 + kk) * ld + sc)); } } while (0)
    int t = c.bx;
    if (t < ntiles) WC_LOAD(t);
    for (; t < ntiles; t += c.G) {
#pragma unroll
        for (int it = 0; it < 8; ++it) { const int idx = it * NTHR + tid; const int kk = idx >> 6, nn4 = (idx & 63) * 4; *(f32x4*)(tile + kk * 260 + nn4) = v[it]; }
        __syncthreads();
        if (t + c.G < ntiles) WC_LOAD(t + c.G);
        {
            const int bi = t / ntb, tr = t - bi * ntb; const int tn = tr % ntn, tk = tr / ntn;
            const int nn = tid >> 1, kh = tid & 1;
            bf16_t* dp = dst0 + (size_t)bi * nd * 2048 + (size_t)(tn * 256 + nn) * 2048 + tk * 64 + kh * 32;
#pragma unroll
            for (int q = 0; q < 4; ++q) {
                float x[8];
#pragma unroll
                for (int j = 0; j < 8; ++j) x[j] = tile[(kh * 32 + q * 8 + j) * 260 + nn];
                u32x4 w; w.x = cvt_pk_bf16(x[0], x[1]); w.y = cvt_pk_bf16(x[2], x[3]); w.z = cvt_pk_bf16(x[4], x[5]); w.w = cvt_pk_bf16(x[6], x[7]);
                *(u32x4*)(dp + q * 8) = w;
            }
        }
        __syncthreads();
    }
#undef WC_LOAD
}

__device__ __forceinline__ void row_pass(const Ctx& c, int mode, const float* gpre, const float* gpost) {
    const float* xin = (mode == 2) ? c.a.out : c.a.x;
    const bf16_t* outf = (const bf16_t*)(c.a.ws + WS_OUTF);
    bf16_t* H = (bf16_t*)(c.a.ws + WS_H);
    for (int row = c.bx * 8 + c.wid; row < MT; row += c.G * 8) {
        f32x4 xv[8];
        const size_t base = (size_t)row * DM;
#pragma unroll
        for (int it = 0; it < 8; ++it) xv[it] = __builtin_nontemporal_load((const f32x4*)(xin + base + it * 256 + c.lane * 4));
        if (mode != 0) {
            f32x4 ov[8]; float ss = 0.f;
#pragma unroll
            for (int it = 0; it < 8; ++it) { const u32x2 rw = __builtin_nontemporal_load((const u32x2*)(outf + base + it * 256 + c.lane * 4)); ov[it] = (f32x4){bflo(rw.x), bfhi(rw.x), bflo(rw.y), bfhi(rw.y)}; ss += ov[it][0] * ov[it][0] + ov[it][1] * ov[it][1] + ov[it][2] * ov[it][2] + ov[it][3] * ov[it][3]; }
            ss = wave_sum(ss); const float ri = rsqrtf(ss * (1.f / DM) + EPS);
#pragma unroll
            for (int it = 0; it < 8; ++it) { const f32x4 gp = *(const f32x4*)(gpost + it * 256 + c.lane * 4); xv[it] += ov[it] * ri * gp; __builtin_nontemporal_store(xv[it], (f32x4*)(c.a.out + base + it * 256 + c.lane * 4)); }
        }
        if (mode != 2) {
            float ss = 0.f;
#pragma unroll
            for (int it = 0; it < 8; ++it) ss += xv[it][0] * xv[it][0] + xv[it][1] * xv[it][1] + xv[it][2] * xv[it][2] + xv[it][3] * xv[it][3];
            ss = wave_sum(ss); const float ri = rsqrtf(ss * (1.f / DM) + EPS);
#pragma unroll
            for (int it = 0; it < 8; ++it) { const f32x4 g = *(const f32x4*)(gpre + it * 256 + c.lane * 4); const f32x4 hv = xv[it] * ri * g;
                u32x2 w; w.x = cvt_pk_bf16(hv[0], hv[1]); w.y = cvt_pk_bf16(hv[2], hv[3]); *(u32x2*)(H + base + it * 256 + c.lane * 4) = w; }
        }
    }
}

__device__ __forceinline__ void bias_table(const Ctx& c) {
    float* tb = (float*)(c.a.ws + WS_TB);
    for (int e = c.tid; e < 8 * 257; e += NTHR) {
        const int h = e / 257, idx = e % 257, rel = idx - 128;
        const int n = rel < 0 ? -rel : rel; const int ret = rel > 0 ? 16 : 0;
        const float nf = (float)(n > 1 ? n : 1);
        int large = 8 + (int)(logf(nf / 8.f) / 2.772588722239781f * 8.f);
        large = large < 15 ? large : 15;
        const int bucket = ret + (n < 8 ? n : large);
        tb[h * 260 + idx] = c.a.rel_bias[bucket * 8 + h] * (1.f / att::SCALE);
    }
}

constexpr int G_QA = 0, G_KB = 33792, G_KBT = 67584, G_VT = 104448, G_SC = 122880, G_LR = 132096, G_QS = 136192, G_ER = 140288, G_CC = 141312;
template <int OFF> __device__ __forceinline__ u32x4 lds_rd128(int addr) { u32x4 r; asm volatile("ds_read_b128 %0, %1 offset:%2" : "=&v"(r) : "v"(addr), "i"(OFF) : "memory"); return r; }
template <int OFF> __device__ __forceinline__ f32x4 lds_rdf(int addr) { f32x4 r; asm volatile("ds_read_b128 %0, %1 offset:%2" : "=&v"(r) : "v"(addr), "i"(OFF) : "memory"); return r; }
template <int OFF> __device__ __forceinline__ u32x2 lds_rd64(int addr) { u32x2 r; asm volatile("ds_read_b64 %0, %1 offset:%2" : "=&v"(r) : "v"(addr), "i"(OFF) : "memory"); return r; }
#define LWAIT() do { asm volatile("s_waitcnt lgkmcnt(0)" ::: "memory"); __builtin_amdgcn_sched_barrier(0); } while (0)
#define AS8(x) (*reinterpret_cast<const bf16x8*>(&(x)))
__device__ __forceinline__ bf16x8 pka_(u32x2 lo, u32x2 hi) { u32x4 w; w.x = lo.x; w.y = lo.y; w.z = hi.x; w.w = hi.y; return *reinterpret_cast<bf16x8*>(&w); }
#define PKA(l, h) pka_(l, h)
constexpr int A2_K0 = 0, A2_K1 = 17408, A2_V0 = 34816, A2_V1 = 71680, A2_TB = 108544;
__device__ __forceinline__ void attn2_item(const Ctx& c, int b, int h, int map, int qb) {
    char* lds = c.lds;
    const bf16_t* P = (const bf16_t*)(c.a.ws + WS_P);
    const bf16_t* Kh = P + (size_t)(b * SEQ) * LDP + C_CK + h * 256 + map * 128;
    const bf16_t* Vh = P + (size_t)(b * SEQ) * LDP + C_CV + h * 256;
    constexpr float SC = att::SCALE, C2 = att::SCALE * 1.4426950408889634f, THRR = att::THR / att::SCALE;
    int az = 0; asm volatile("" : "+v"(az));
    const int tid = c.tid + az, lane = tid & 63, w = c.wid, m16 = lane & 15, g4 = lane >> 4;
    const int q0w = qb * 128 + w * 16;
    float* tb_l = (float*)(lds + A2_TB);
    __syncthreads();
    if (tid < 257) {
        const int rel = tid - 128; const int n = rel < 0 ? -rel : rel; const int ret = rel > 0 ? 16 : 0;
        const float nf = (float)(n > 1 ? n : 1);
        int large = 8 + (int)(logf(nf / 8.f) / 2.772588722239781f * 8.f);
        large = large < 15 ? large : 15;
        const int bucket = ret + (n < 8 ? n : large);
        tb_l[tid] = c.a.rel_bias[bucket * 8 + h] * (1.f / SC);
    }
    const float cL = c.a.rel_bias[15 * 8 + h] * (1.f / SC), cR = c.a.rel_bias[31 * 8 + h] * (1.f / SC);
    bf16x8 qreg[4];
    {
        const bf16_t* Qw = P + (size_t)(b * SEQ + q0w + m16) * LDP + C_CQ + h * 256 + map * 128 + 8 * g4;
#pragma unroll
        for (int ks = 0; ks < 4; ++ks) qreg[ks] = *(const bf16x8*)(Qw + 32 * ks);
    }
    f32x4 o[16];
#pragma unroll
    for (int vt = 0; vt < 16; ++vt) o[vt] = (f32x4){0.f, 0.f, 0.f, 0.f};
    float m_reg = -1e30f, l_reg = 0.f;
    u32x4 sk[2][2]; unsigned sv[2][16];
#define A2_LOAD(sl, k0) do { _Pragma("unroll") for (int it = 0; it < 2; ++it) { const int v = it * NTHR + tid; sk[sl][it] = *(const u32x4*)(Kh + (size_t)((k0) + (v >> 4)) * LDP + (v & 15) * 8); } \
        _Pragma("unroll") for (int it = 0; it < 2; ++it) { const int u = it * NTHR + tid; const int cp = u & 127, kg = u >> 7; const bf16_t* vp = Vh + (size_t)((k0) + kg * 8) * LDP + 2 * cp; \
            _Pragma("unroll") for (int x = 0; x < 8; ++x) sv[sl][it * 8 + x] = *(const unsigned*)(vp + (size_t)x * LDP); } } while (0)
#define A2_LO2(x, y) __builtin_amdgcn_perm((y), (x), 0x05040100u)
#define A2_HI2(x, y) __builtin_amdgcn_perm((y), (x), 0x07060302u)
#define A2_WRITE(sl, buf) do { char* kb_ = lds + ((buf) ? A2_K1 : A2_K0); char* vb_ = lds + ((buf) ? A2_V1 : A2_V0); \
        _Pragma("unroll") for (int it = 0; it < 2; ++it) { const int v = it * NTHR + tid; *(u32x4*)(kb_ + (v >> 4) * 272 + (v & 15) * 16) = sk[sl][it]; } \
        _Pragma("unroll") for (int it = 0; it < 2; ++it) { const int u = it * NTHR + tid; const int cp = u & 127, kg = u >> 7; u32x4 a_, b_; \
            a_.x = A2_LO2(sv[sl][it * 8 + 0], sv[sl][it * 8 + 1]); a_.y = A2_LO2(sv[sl][it * 8 + 2], sv[sl][it * 8 + 3]); a_.z = A2_LO2(sv[sl][it * 8 + 4], sv[sl][it * 8 + 5]); a_.w = A2_LO2(sv[sl][it * 8 + 6], sv[sl][it * 8 + 7]); \
            b_.x = A2_HI2(sv[sl][it * 8 + 0], sv[sl][it * 8 + 1]); b_.y = A2_HI2(sv[sl][it * 8 + 2], sv[sl][it * 8 + 3]); b_.z = A2_HI2(sv[sl][it * 8 + 4], sv[sl][it * 8 + 5]); b_.w = A2_HI2(sv[sl][it * 8 + 6], sv[sl][it * 8 + 7]); \
            *(u32x4*)(vb_ + cp * 144 + kg * 16) = a_; *(u32x4*)(vb_ + (128 + cp) * 144 + kg * 16) = b_; } } while (0)
    A2_LOAD(0, 0);
    A2_WRITE(0, 0);
    LBAR();
    A2_LOAD(0, 64); A2_LOAD(1, 128);
    for (int j2 = 0; j2 < 32; j2 += 2) {
#pragma unroll
      for (int half = 0; half < 2; ++half) {
        const int j = j2 + half, buf = half;
        __builtin_amdgcn_sched_barrier(0);
        const int bK = (int)(uintptr_t)(lds + (buf ? A2_K1 : A2_K0)) + m16 * 272 + g4 * 16;
        const int bV = (int)(uintptr_t)(lds + (buf ? A2_V1 : A2_V0)) + m16 * 144 + g4 * 8;
        const int relw = j * 64 - q0w;
        const bool farL = (relw + 63 <= -91), farR = (relw - 15 >= 91);
        const float ini = farL ? cL : (farR ? cR : 0.f);
        f32x4 p[4];
#pragma unroll
        for (int kt = 0; kt < 4; ++kt) p[kt] = (f32x4){0.f, 0.f, 0.f, 0.f};
#define A2_KR(kt, ks) lds_rd128<(kt) * 4352 + (ks) * 64>(bK)
#define A2_MK(kt, ks, A) p[kt] = __builtin_amdgcn_mfma_f32_16x16x32_bf16(AS8(A), qreg[ks], p[kt], 0, 0, 0)
        {
            const u32x4 a00 = A2_KR(0, 0), a01 = A2_KR(0, 1), a02 = A2_KR(0, 2), a03 = A2_KR(0, 3), a10 = A2_KR(1, 0), a11 = A2_KR(1, 1), a12 = A2_KR(1, 2), a13 = A2_KR(1, 3);
            LWAIT();
            A2_MK(0, 0, a00); A2_MK(1, 0, a10); A2_MK(0, 1, a01); A2_MK(1, 1, a11); A2_MK(0, 2, a02); A2_MK(1, 2, a12); A2_MK(0, 3, a03); A2_MK(1, 3, a13);
        }
        {
            const u32x4 a20 = A2_KR(2, 0), a21 = A2_KR(2, 1), a22 = A2_KR(2, 2), a23 = A2_KR(2, 3), a30 = A2_KR(3, 0), a31 = A2_KR(3, 1), a32 = A2_KR(3, 2), a33 = A2_KR(3, 3);
            LWAIT();
            A2_MK(2, 0, a20); A2_MK(3, 0, a30); A2_MK(2, 1, a21); A2_MK(3, 1, a31); A2_MK(2, 2, a22); A2_MK(3, 2, a32); A2_MK(2, 3, a23); A2_MK(3, 3, a33);
        }
#undef A2_KR
#undef A2_MK
#define A2_VR(vt, kt) lds_rd64<(vt) * 2304 + (kt) * 32>(bV)
#define A2_VLOAD(P_, vt0) \
        const u32x2 P_##00 = A2_VR((vt0) + 0, 0), P_##01 = A2_VR((vt0) + 0, 1), P_##02 = A2_VR((vt0) + 0, 2), P_##03 = A2_VR((vt0) + 0, 3), P_##10 = A2_VR((vt0) + 1, 0), P_##11 = A2_VR((vt0) + 1, 1), P_##12 = A2_VR((vt0) + 1, 2), P_##13 = A2_VR((vt0) + 1, 3); \
        const u32x2 P_##20 = A2_VR((vt0) + 2, 0), P_##21 = A2_VR((vt0) + 2, 1), P_##22 = A2_VR((vt0) + 2, 2), P_##23 = A2_VR((vt0) + 2, 3), P_##30 = A2_VR((vt0) + 3, 0), P_##31 = A2_VR((vt0) + 3, 1), P_##32 = A2_VR((vt0) + 3, 2), P_##33 = A2_VR((vt0) + 3, 3);
#define A2_MV0(vt, X0, X1) o[vt] = __builtin_amdgcn_mfma_f32_16x16x32_bf16(PKA(X0, X1), AS8(bw0), o[vt], 0, 0, 0)
#define A2_MV1(vt, X2, X3) o[vt] = __builtin_amdgcn_mfma_f32_16x16x32_bf16(PKA(X2, X3), AS8(bw1), o[vt], 0, 0, 0)
#define A2_VMMA(P_, vt0) do { A2_MV0((vt0) + 0, P_##00, P_##01); A2_MV0((vt0) + 1, P_##10, P_##11); A2_MV0((vt0) + 2, P_##20, P_##21); A2_MV0((vt0) + 3, P_##30, P_##31); \
        A2_MV1((vt0) + 0, P_##02, P_##03); A2_MV1((vt0) + 1, P_##12, P_##13); A2_MV1((vt0) + 2, P_##22, P_##23); A2_MV1((vt0) + 3, P_##32, P_##33); } while (0)
        A2_VLOAD(va, 0)
        if (!(farL || farR)) {
            const int rel0 = relw - m16 + 4 * g4 + 128;
#pragma unroll
            for (int kt = 0; kt < 4; ++kt)
#pragma unroll
                for (int r = 0; r < 4; ++r) { int ix = rel0 + 16 * kt + r; ix = min(max(ix, 0), 256); p[kt][r] += tb_l[ix]; }
        }
        float pmax = p[0][0];
#pragma unroll
        for (int kt = 0; kt < 4; ++kt)
#pragma unroll
            for (int r = 0; r < 4; ++r) pmax = fmaxf(pmax, p[kt][r]);
        { auto rr = __builtin_amdgcn_permlane16_swap(__float_as_uint(pmax), __float_as_uint(pmax), false, false); pmax = fmaxf(__uint_as_float(rr[0]), __uint_as_float(rr[1])); }
        { auto rr = __builtin_amdgcn_permlane32_swap(__float_as_uint(pmax), __float_as_uint(pmax), false, false); pmax = fmaxf(__uint_as_float(rr[0]), __uint_as_float(rr[1])); }
        pmax += ini;
        if (!__all(pmax - m_reg <= THRR)) {
            const float mn = fmaxf(m_reg, pmax); const float alpha = __builtin_amdgcn_exp2f((m_reg - mn) * C2); m_reg = mn;
            l_reg *= alpha;
#pragma unroll
            for (int vt = 0; vt < 16; ++vt) o[vt] *= alpha;
        }
        const float mnC = (ini - m_reg) * C2; float ps = 0.f;
#pragma unroll
        for (int kt = 0; kt < 4; ++kt)
#pragma unroll
            for (int r = 0; r < 4; ++r) { const float e = __builtin_amdgcn_exp2f(fmaf(p[kt][r], C2, mnC)); p[kt][r] = e; ps += e; }
        l_reg += ps;
        u32x4 bw0, bw1;
        bw0.x = cvt_pk_bf16(p[0][0], p[0][1]); bw0.y = cvt_pk_bf16(p[0][2], p[0][3]); bw0.z = cvt_pk_bf16(p[1][0], p[1][1]); bw0.w = cvt_pk_bf16(p[1][2], p[1][3]);
        bw1.x = cvt_pk_bf16(p[2][0], p[2][1]); bw1.y = cvt_pk_bf16(p[2][2], p[2][3]); bw1.z = cvt_pk_bf16(p[3][0], p[3][1]); bw1.w = cvt_pk_bf16(p[3][2], p[3][3]);
        LWAIT();
        A2_VMMA(va, 0);
        { A2_VLOAD(vb, 4) LWAIT(); A2_VMMA(vb, 4); }
        { A2_VLOAD(vc, 8) LWAIT(); A2_VMMA(vc, 8); }
        { A2_VLOAD(vd, 12) LWAIT(); A2_VMMA(vd, 12); }
#undef A2_VR
#undef A2_VLOAD
#undef A2_MV0
#undef A2_MV1
#undef A2_VMMA
        __builtin_amdgcn_sched_barrier(0);
        A2_WRITE(half, buf ^ 1);
        LBAR();
        { const int jn = (j + 3 < 32) ? j + 3 : 31; A2_LOAD(half, jn * 64); }
      }
    }
    l_reg += __shfl_xor(l_reg, 16); l_reg += __shfl_xor(l_reg, 32);
    const float rl = __builtin_amdgcn_rcpf(l_reg);
    bf16_t* Ob = (bf16_t*)(c.a.ws + WS_OA) + ((size_t)map * MT + b * SEQ + q0w + m16) * DM + h * 256 + 8 * g4;
#pragma unroll
    for (int vt = 0; vt < 8; ++vt) {
        u32x4 wv; wv.x = cvt_pk_bf16(o[vt][0] * rl, o[vt + 8][0] * rl); wv.y = cvt_pk_bf16(o[vt][1] * rl, o[vt + 8][1] * rl);
        wv.z = cvt_pk_bf16(o[vt][2] * rl, o[vt + 8][2] * rl); wv.w = cvt_pk_bf16(o[vt][3] * rl, o[vt + 8][3] * rl);
        __builtin_nontemporal_store(wv, (u32x4*)(Ob + 32 * vt));
    }
#undef A2_LOAD
#undef A2_WRITE
#undef A2_LO2
#undef A2_HI2
}

#define OPQ(v) ({ int _z = 0; asm volatile("" : "+v"(_z)); (v) + _z; })
#define GROW(nn, i) (b * SEQ + (dir ? (SEQ - 1 - ((nn) * 64 + (i))) : ((nn) * 64 + (i))))
__device__ __forceinline__ void gla_lr_block(const Ctx& c, int b, int nb) {
    char* lds = c.lds;
    const bf16_t* H = (const bf16_t*)(c.a.ws + WS_H) + (size_t)(b * SEQ + nb * 64) * DM;
    const bf16_t* WL = (const bf16_t*)(c.a.ws + WS_W) + (size_t)20480 * DM;
    const int w = c.wid; const int ln = OPQ(c.lane); const int m16 = ln & 15, g4 = ln >> 4;
    f32x4 acc[4][2];
#pragma unroll
    for (int rt = 0; rt < 4; ++rt) { acc[rt][0] = (f32x4){0.f, 0.f, 0.f, 0.f}; acc[rt][1] = (f32x4){0.f, 0.f, 0.f, 0.f}; }
#pragma unroll 2
    for (int ks = 0; ks < 8; ++ks) {
        const int k0 = 256 * w + 32 * ks + 8 * g4;
        const bf16x8 b0 = *(const bf16x8*)(WL + (size_t)m16 * DM + k0), b1 = *(const bf16x8*)(WL + (size_t)(16 + m16) * DM + k0);
#pragma unroll
        for (int rt = 0; rt < 4; ++rt) {
            const bf16x8 av = *(const bf16x8*)(H + (size_t)(rt * 16 + m16) * DM + k0);
            acc[rt][0] = __builtin_amdgcn_mfma_f32_16x16x32_bf16(av, b0, acc[rt][0], 0, 0, 0);
            acc[rt][1] = __builtin_amdgcn_mfma_f32_16x16x32_bf16(av, b1, acc[rt][1], 0, 0, 0);
        }
    }
    LBAR();
#pragma unroll
    for (int rt = 0; rt < 4; ++rt)
#pragma unroll
        for (int ct = 0; ct < 2; ++ct)
#pragma unroll
            for (int r = 0; r < 4; ++r) *(float*)(lds + G_QA + ((w * 64 + rt * 16 + 4 * g4 + r) * 32 + ct * 16 + m16) * 4) = acc[rt][ct][r];
    LBAR();
    {
        const int tc = OPQ(c.tid);
        f32x4 sacc = (f32x4){0.f, 0.f, 0.f, 0.f};
#pragma unroll
        for (int w2 = 0; w2 < 8; ++w2) sacc += *(const f32x4*)(lds + G_QA + (w2 * 2048 + tc * 4) * 4);
        *(f32x4*)(lds + G_VT + tc * 16) = sacc;
    }
    LBAR();
}

__device__ __forceinline__ void gla_pre_item(const Ctx& c, int l, int b, int h, int dir, int n) {
    char* lds = c.lds;
    const bf16_t* P = (const bf16_t*)(c.a.ws + WS_P);
    const int ci = ((b * 4 + h) * 2 + dir) * 32 + n;
    const int w = c.wid;
    const int te = OPQ(c.tid); const int dp = te & 127, qr = te >> 7;
    const int rstep = dir ? -LDP : LDP;
    unsigned rq[16], rk[16];
    {
        const bf16_t* Pn = P + (size_t)GROW(n, 0) * LDP; const int t0 = (C_BQ + h * 256 + 2 * dp) + 16 * qr * rstep;
#pragma unroll
        for (int i = 0; i < 16; ++i) { rq[i] = *(const unsigned*)(Pn + (t0 + i * rstep)); rk[i] = *(const unsigned*)(Pn + (t0 + i * rstep + (C_BK - C_BQ))); }
    }
    float wa0[16], wa1[16];
    {
        const float* wp = c.a.wa2 + ((size_t)(l * 2 + dir) * 16) * 1024 + h * 256 + 2 * dp;
#pragma unroll
        for (int r = 0; r < 16; ++r) { const f32x2 t = *(const f32x2*)(wp + r * 1024); wa0[r] = t.x; wa1[r] = t.y; }
    }
    const f32x2 bav = *(const f32x2*)(c.a.ba + (size_t)(l * 2 + dir) * 1024 + h * 256 + 2 * dp);
    LBAR();
    float cl0[16], cl1[16];
    {
        float run0 = 0.f, run1 = 0.f;
#pragma unroll
        for (int i = 0; i < 16; ++i) {
            const int ii = dir ? (63 - (16 * qr + i)) : (16 * qr + i);
            const float* lp = (const float*)(lds + G_VT) + ii * 32 + dir * 16;
            float z0 = bav.x, z1 = bav.y;
#pragma unroll
            for (int r4 = 0; r4 < 4; ++r4) { const f32x4 t = *(const f32x4*)(lp + 4 * r4);
#pragma unroll
                for (int j = 0; j < 4; ++j) { z0 = fmaf(t[j], wa0[4 * r4 + j], z0); z1 = fmaf(t[j], wa1[4 * r4 + j], z1); } }
            run0 += logsig(z0) * 0.0625f; run1 += logsig(z1) * 0.0625f; cl0[i] = run0; cl1[i] = run1;
        }
        *(f32x2*)(lds + G_QS + (qr * 256 + 2 * dp) * 4) = (f32x2){run0, run1};
    }
    LBAR();
    {
        const f32x2 s0 = *(const f32x2*)(lds + G_QS + (0 * 256 + 2 * dp) * 4), s1 = *(const f32x2*)(lds + G_QS + (1 * 256 + 2 * dp) * 4);
        const f32x2 s2 = *(const f32x2*)(lds + G_QS + (2 * 256 + 2 * dp) * 4), s3 = *(const f32x2*)(lds + G_QS + (3 * 256 + 2 * dp) * 4);
        const f32x2 ref = s0 + s1, last = ref + s2 + s3;
        f32x2 pre = (f32x2){0.f, 0.f};
        if (qr > 0) pre += s0; if (qr > 1) pre += s1; if (qr > 2) pre += s2;
#define LO2(x, y) (((x) & 0xffffu) | ((y) << 16))
#define HI2(x, y) (((x) >> 16) | ((y) & 0xffff0000u))
        const float er0 = __expf(ref.x), er1 = __expf(ref.y), cc0 = __expf(last.x - ref.x), cc1 = __expf(last.y - ref.y);
        unsigned char* gq = c.a.ws + WS_GQA + (size_t)ci * 32768; unsigned char* gk = c.a.ws + WS_GKT + (size_t)ci * 32768;
#pragma unroll
        for (int hf = 0; hf < 2; ++hf) {
            unsigned ks[8];
#pragma unroll
            for (int ii = 0; ii < 8; ++ii) {
                const int i = hf * 8 + ii;
                const float c0 = cl0[i] + pre.x, c1 = cl1[i] + pre.y;
                const float ea0 = __expf(c0 - ref.x), ea1 = __expf(c1 - ref.y), eb0 = __expf(ref.x - c0), eb1 = __expf(ref.y - c1);
                const float qa0 = bflo(rq[i]) * ea0, qa1 = bfhi(rq[i]) * ea1, kb0 = bflo(rk[i]) * eb0, kb1 = bfhi(rk[i]) * eb1;
                *(unsigned*)(lds + G_QA + (16 * qr + i) * 528 + dp * 4) = cvt_pk_bf16(qa0, qa1);
                *(unsigned*)(lds + G_KB + (16 * qr + i) * 528 + dp * 4) = cvt_pk_bf16(kb0, kb1);
                *(unsigned*)(gq + ((16 * qr + i) * 256 + 2 * dp) * 2) = cvt_pk_bf16(qa0 * er0, qa1 * er1);
                ks[ii] = cvt_pk_bf16(kb0 * cc0, kb1 * cc1);
            }
            u32x4 a0, b0;
            a0.x = LO2(ks[0], ks[1]); a0.y = LO2(ks[2], ks[3]); a0.z = LO2(ks[4], ks[5]); a0.w = LO2(ks[6], ks[7]);
            b0.x = HI2(ks[0], ks[1]); b0.y = HI2(ks[2], ks[3]); b0.z = HI2(ks[4], ks[5]); b0.w = HI2(ks[6], ks[7]);
            *(u32x4*)(gk + ((2 * dp) * 64 + 16 * qr + hf * 8) * 2) = a0;
            *(u32x4*)(gk + ((2 * dp + 1) * 64 + 16 * qr + hf * 8) * 2) = b0;
        }
#undef LO2
#undef HI2
        if (qr == 0) *(f32x2*)(lds + G_ER + 2 * dp * 4) = (f32x2){__expf(last.x), __expf(last.y)};
    }
    LBAR();
    {
        const int ln5 = OPQ(c.lane); const int m16 = ln5 & 15, g4 = ln5 >> 4;
#pragma unroll
        for (int s = 0; s < 2; ++s) {
            const int idx = 2 * w + s, ti = idx >> 2, tj = idx & 3;
            f32x4 cc = (f32x4){0.f, 0.f, 0.f, 0.f};
            if (tj <= ti) {
#pragma unroll
                for (int ks = 0; ks < 8; ++ks) {
                    const bf16x8 av = *(const bf16x8*)(lds + G_QA + (16 * ti + m16) * 528 + (32 * ks + 8 * g4) * 2);
                    const bf16x8 bv = *(const bf16x8*)(lds + G_KB + (16 * tj + m16) * 528 + (32 * ks + 8 * g4) * 2);
                    cc = __builtin_amdgcn_mfma_f32_16x16x32_bf16(av, bv, cc, 0, 0, 0);
                }
                if (ti == tj) {
#pragma unroll
                    for (int r = 0; r < 4; ++r) if (m16 > 4 * g4 + r) cc[r] = 0.f;
                }
            }
#pragma unroll
            for (int r = 0; r < 4; ++r) *(bf16_t*)(lds + G_SC + (16 * ti + 4 * g4 + r) * 144 + (16 * tj + m16) * 2) = f2bf(cc[r]);
        }
    }
    LBAR();
    {
        const int tc = OPQ(c.tid);
        *(u32x4*)(c.a.ws + WS_GSC + (size_t)ci * 8192 + tc * 16) = *(const u32x4*)(lds + G_SC + (tc >> 3) * 144 + (tc & 7) * 16);
        if (tc < 64) *(u32x4*)(c.a.ws + WS_GEC + (size_t)ci * 2048 + tc * 16) = *(const u32x4*)(lds + G_ER + tc * 16);
    }
}

__device__ __forceinline__ void gla_scan_item(const Ctx& c, int l, int b, int h, int dir, int dvs) {
    char* lds = c.lds;
    const bf16_t* P = (const bf16_t*)(c.a.ws + WS_P);
    bf16_t* og = (bf16_t*)(c.a.ws + WS_OG) + (size_t)dir * MT * DM;
    const int w = c.wid;
    const int ci0 = ((b * 4 + h) * 2 + dir) * 32;
    const int rstep = dir ? -LDP : LDP;
    f32x4 S[16];
#pragma unroll
    for (int t = 0; t < 16; ++t) S[t] = (f32x4){0.f, 0.f, 0.f, 0.f};
    u32x4 pq[4], pk[4], ps, pe; unsigned rv[8];
#define GS_LOAD(nn, tz) do { const int tc = c.tid + (tz); const size_t ci = (size_t)(ci0 + (nn)); \
        const unsigned char* gq = c.a.ws + WS_GQA + ci * 32768; const unsigned char* gk = c.a.ws + WS_GKT + ci * 32768; \
        _Pragma("unroll") for (int it = 0; it < 4; ++it) { pq[it] = *(const u32x4*)(gq + (it * NTHR + tc) * 16); pk[it] = *(const u32x4*)(gk + (it * NTHR + tc) * 16); } \
        ps = *(const u32x4*)(c.a.ws + WS_GSC + ci * 8192 + tc * 16); \
        pe = *(const u32x4*)(c.a.ws + WS_GEC + ci * 2048 + (tc & 63) * 16); \
        { const int ep = tc & 63, q8 = tc >> 6; const bf16_t* Pn = P + (size_t)GROW(nn, 0) * LDP; const int t0 = (C_BV + h * 512 + dvs * 128 + 2 * ep) + 8 * q8 * rstep; \
          _Pragma("unroll") for (int x = 0; x < 8; ++x) rv[x] = __builtin_nontemporal_load((const unsigned*)(Pn + (t0 + x * rstep))); } } while (0)
    { int tz = 0; asm volatile("" : "+v"(tz)); GS_LOAD(0, tz); }
    for (int n = 0; n < 32; ++n) {
        int oz = 0; asm volatile("" : "+v"(oz));
        const int tc = c.tid + oz;
        LBAR();
        {
#pragma unroll
            for (int it = 0; it < 4; ++it) { const int v = it * NTHR + tc;
                *(u32x4*)(lds + G_QA + (v >> 5) * 528 + (v & 31) * 16) = pq[it];
                *(u32x4*)(lds + G_KBT + (v >> 3) * 144 + (v & 7) * 16) = pk[it]; }
            *(u32x4*)(lds + G_SC + (tc >> 3) * 144 + (tc & 7) * 16) = ps;
            if (tc < 64) *(u32x4*)(lds + G_ER + tc * 16) = pe;
            const int ep = tc & 63, q8 = tc >> 6;
#define LO2(x, y) (((x) & 0xffffu) | ((y) << 16))
#define HI2(x, y) (((x) >> 16) | ((y) & 0xffff0000u))
            u32x4 v0, v1;
            v0.x = LO2(rv[0], rv[1]); v0.y = LO2(rv[2], rv[3]); v0.z = LO2(rv[4], rv[5]); v0.w = LO2(rv[6], rv[7]);
            v1.x = HI2(rv[0], rv[1]); v1.y = HI2(rv[2], rv[3]); v1.z = HI2(rv[4], rv[5]); v1.w = HI2(rv[6], rv[7]);
            *(u32x4*)(lds + G_VT + (2 * ep) * 144 + q8 * 16) = v0; *(u32x4*)(lds + G_VT + (2 * ep + 1) * 144 + q8 * 16) = v1;
#undef LO2
#undef HI2
        }
        LBAR();
        { const int nn = (n + 1 < 32) ? n + 1 : 31; GS_LOAD(nn, oz); }
        __builtin_amdgcn_sched_barrier(0);
        const int ln = OPQ(c.lane); const int m16 = ln & 15, g4 = ln >> 4;
        const int bA = (int)(uintptr_t)(lds + G_QA) + m16 * 528 + g4 * 8;
        const int bSC = (int)(uintptr_t)(lds + G_SC) + m16 * 144 + g4 * 16;
        const int bKT = (int)(uintptr_t)(lds + G_KBT) + m16 * 144 + g4 * 16;
        const int bF = (int)(uintptr_t)(lds + G_ER) + g4 * 16;
        const int bVT = (int)(uintptr_t)(lds + G_VT) + (16 * w + m16) * 144 + g4 * 16;
        f32x4 o[4];
#pragma unroll
        for (int ti = 0; ti < 4; ++ti) o[ti] = (f32x4){0.f, 0.f, 0.f, 0.f};
#define Q6(ks) do { \
        const u32x2 l0 = lds_rd64<0 * 8448 + (ks) * 64>(bA), h0 = lds_rd64<0 * 8448 + (ks) * 64 + 32>(bA), l1 = lds_rd64<1 * 8448 + (ks) * 64>(bA), h1 = lds_rd64<1 * 8448 + (ks) * 64 + 32>(bA); \
        const u32x2 l2 = lds_rd64<2 * 8448 + (ks) * 64>(bA), h2 = lds_rd64<2 * 8448 + (ks) * 64 + 32>(bA), l3 = lds_rd64<3 * 8448 + (ks) * 64>(bA), h3 = lds_rd64<3 * 8448 + (ks) * 64 + 32>(bA); \
        const u32x2 m0 = lds_rd64<0 * 8448 + (ks) * 64 + 64>(bA), n0 = lds_rd64<0 * 8448 + (ks) * 64 + 96>(bA), m1 = lds_rd64<1 * 8448 + (ks) * 64 + 64>(bA), n1 = lds_rd64<1 * 8448 + (ks) * 64 + 96>(bA); \
        const u32x2 m2 = lds_rd64<2 * 8448 + (ks) * 64 + 64>(bA), n2 = lds_rd64<2 * 8448 + (ks) * 64 + 96>(bA), m3 = lds_rd64<3 * 8448 + (ks) * 64 + 64>(bA), n3 = lds_rd64<3 * 8448 + (ks) * 64 + 96>(bA); \
        u32x4 bw0, bw1; bw0.x = cvt_pk_bf16(S[2 * (ks)][0], S[2 * (ks)][1]); bw0.y = cvt_pk_bf16(S[2 * (ks)][2], S[2 * (ks)][3]); \
        bw0.z = cvt_pk_bf16(S[2 * (ks) + 1][0], S[2 * (ks) + 1][1]); bw0.w = cvt_pk_bf16(S[2 * (ks) + 1][2], S[2 * (ks) + 1][3]); \
        bw1.x = cvt_pk_bf16(S[2 * (ks) + 2][0], S[2 * (ks) + 2][1]); bw1.y = cvt_pk_bf16(S[2 * (ks) + 2][2], S[2 * (ks) + 2][3]); \
        bw1.z = cvt_pk_bf16(S[2 * (ks) + 3][0], S[2 * (ks) + 3][1]); bw1.w = cvt_pk_bf16(S[2 * (ks) + 3][2], S[2 * (ks) + 3][3]); \
        LWAIT(); \
        o[0] = __builtin_amdgcn_mfma_f32_16x16x32_bf16(PKA(l0, h0), AS8(bw0), o[0], 0, 0, 0); o[1] = __builtin_amdgcn_mfma_f32_16x16x32_bf16(PKA(l1, h1), AS8(bw0), o[1], 0, 0, 0); \
        o[2] = __builtin_amdgcn_mfma_f32_16x16x32_bf16(PKA(l2, h2), AS8(bw0), o[2], 0, 0, 0); o[3] = __builtin_amdgcn_mfma_f32_16x16x32_bf16(PKA(l3, h3), AS8(bw0), o[3], 0, 0, 0); \
        o[0] = __builtin_amdgcn_mfma_f32_16x16x32_bf16(PKA(m0, n0), AS8(bw1), o[0], 0, 0, 0); o[1] = __builtin_amdgcn_mfma_f32_16x16x32_bf16(PKA(m1, n1), AS8(bw1), o[1], 0, 0, 0); \
        o[2] = __builtin_amdgcn_mfma_f32_16x16x32_bf16(PKA(m2, n2), AS8(bw1), o[2], 0, 0, 0); o[3] = __builtin_amdgcn_mfma_f32_16x16x32_bf16(PKA(m3, n3), AS8(bw1), o[3], 0, 0, 0); } while (0)
        Q6(0); Q6(2); Q6(4); Q6(6);
#undef Q6
        {
            const u32x4 vb0 = lds_rd128<0>(bVT), vb1 = lds_rd128<64>(bVT);
            const u32x4 s00 = lds_rd128<0 * 2304>(bSC), s01 = lds_rd128<0 * 2304 + 64>(bSC), s10 = lds_rd128<1 * 2304>(bSC), s11 = lds_rd128<1 * 2304 + 64>(bSC);
            const u32x4 s20 = lds_rd128<2 * 2304>(bSC), s21 = lds_rd128<2 * 2304 + 64>(bSC), s30 = lds_rd128<3 * 2304>(bSC), s31 = lds_rd128<3 * 2304 + 64>(bSC);
            LWAIT();
            o[0] = __builtin_amdgcn_mfma_f32_16x16x32_bf16(AS8(s00), AS8(vb0), o[0], 0, 0, 0); o[1] = __builtin_amdgcn_mfma_f32_16x16x32_bf16(AS8(s10), AS8(vb0), o[1], 0, 0, 0);
            o[2] = __builtin_amdgcn_mfma_f32_16x16x32_bf16(AS8(s20), AS8(vb0), o[2], 0, 0, 0); o[3] = __builtin_amdgcn_mfma_f32_16x16x32_bf16(AS8(s30), AS8(vb0), o[3], 0, 0, 0);
            o[0] = __builtin_amdgcn_mfma_f32_16x16x32_bf16(AS8(s01), AS8(vb1), o[0], 0, 0, 0); o[1] = __builtin_amdgcn_mfma_f32_16x16x32_bf16(AS8(s11), AS8(vb1), o[1], 0, 0, 0);
            o[2] = __builtin_amdgcn_mfma_f32_16x16x32_bf16(AS8(s21), AS8(vb1), o[2], 0, 0, 0); o[3] = __builtin_amdgcn_mfma_f32_16x16x32_bf16(AS8(s31), AS8(vb1), o[3], 0, 0, 0);
#define G8(t0) do { \
            const u32x4 k00 = lds_rd128<((t0) + 0) * 2304>(bKT), k01 = lds_rd128<((t0) + 0) * 2304 + 64>(bKT), k10 = lds_rd128<((t0) + 1) * 2304>(bKT), k11 = lds_rd128<((t0) + 1) * 2304 + 64>(bKT); \
            const u32x4 k20 = lds_rd128<((t0) + 2) * 2304>(bKT), k21 = lds_rd128<((t0) + 2) * 2304 + 64>(bKT), k30 = lds_rd128<((t0) + 3) * 2304>(bKT), k31 = lds_rd128<((t0) + 3) * 2304 + 64>(bKT); \
            const f32x4 c0 = lds_rdf<((t0) + 0) * 64>(bF), c1 = lds_rdf<((t0) + 1) * 64>(bF), c2 = lds_rdf<((t0) + 2) * 64>(bF), c3 = lds_rdf<((t0) + 3) * 64>(bF); \
            LWAIT(); \
            S[(t0) + 0] *= c0; S[(t0) + 1] *= c1; S[(t0) + 2] *= c2; S[(t0) + 3] *= c3; \
            S[(t0) + 0] = __builtin_amdgcn_mfma_f32_16x16x32_bf16(AS8(k00), AS8(vb0), S[(t0) + 0], 0, 0, 0); S[(t0) + 1] = __builtin_amdgcn_mfma_f32_16x16x32_bf16(AS8(k10), AS8(vb0), S[(t0) + 1], 0, 0, 0); \
            S[(t0) + 2] = __builtin_amdgcn_mfma_f32_16x16x32_bf16(AS8(k20), AS8(vb0), S[(t0) + 2], 0, 0, 0); S[(t0) + 3] = __builtin_amdgcn_mfma_f32_16x16x32_bf16(AS8(k30), AS8(vb0), S[(t0) + 3], 0, 0, 0); \
            S[(t0) + 0] = __builtin_amdgcn_mfma_f32_16x16x32_bf16(AS8(k01), AS8(vb1), S[(t0) + 0], 0, 0, 0); S[(t0) + 1] = __builtin_amdgcn_mfma_f32_16x16x32_bf16(AS8(k11), AS8(vb1), S[(t0) + 1], 0, 0, 0); \
            S[(t0) + 2] = __builtin_amdgcn_mfma_f32_16x16x32_bf16(AS8(k21), AS8(vb1), S[(t0) + 2], 0, 0, 0); S[(t0) + 3] = __builtin_amdgcn_mfma_f32_16x16x32_bf16(AS8(k31), AS8(vb1), S[(t0) + 3], 0, 0, 0); \
            } while (0)
            G8(0); G8(4);
#pragma unroll
            for (int ti = 0; ti < 4; ++ti) {
#pragma unroll
                for (int r = 0; r < 4; ++r) {
                    const int i = 16 * ti + 4 * g4 + r;
                    __builtin_nontemporal_store(f2bf(o[ti][r]), og + (size_t)GROW(n, i) * DM + h * 512 + dvs * 128 + 16 * w + m16);
                }
            }
            G8(8); G8(12);
#undef G8
        }
    }
    LBAR();
#undef GS_LOAD
}
#undef GROW
#undef OPQ

constexpr int M_WS = 0, M_SV = 34816, M_MU = 34816 + 65536, M_RS = M_MU + 512;
__device__ __forceinline__ void gmlp_item(const Ctx& c, int l, int b, int n, int g) {
    char* lds = c.lds;
    const bf16_t* P = (const bf16_t*)(c.a.ws + WS_P);
    const float* stats = (const float*)(c.a.ws + WS_ST);
    bf16_t* br0 = (bf16_t*)(c.a.ws + WS_BR);
    int gz = 0; asm volatile("" : "+v"(gz));
    const int tid = c.tid + gz, lane = tid & 63, w = c.wid;
    const int T0 = b * SEQ + n * 128;
    __syncthreads();
    if (tid < 128) {
        const float* sp = stats + (size_t)(T0 + tid) * 64; float s = 0.f, q = 0.f;
#pragma unroll
        for (int x = 0; x < 16; ++x) { const f32x4 t = *(const f32x4*)(sp + 4 * x); s += t[0] + t[2]; q += t[1] + t[3]; }
        const float mu = s * (1.f / 2048.f); const float var = fmaxf(q * (1.f / 2048.f) - mu * mu, 0.f);
        *(float*)(lds + M_MU + tid * 4) = mu; *(float*)(lds + M_RS + tid * 4) = rsqrtf(var + EPS);
    }
    {
        const float* wp = c.a.gws + ((size_t)(l * 8 + g) * 128) * 128;
#pragma unroll
        for (int it = 0; it < 8; ++it) { const int e = (it * NTHR + tid) * 4; const int p = e >> 7, q = e & 127;
            const f32x4 t = *(const f32x4*)(wp + e); u32x2 wv; wv.x = cvt_pk_bf16(t[0], t[1]); wv.y = cvt_pk_bf16(t[2], t[3]);
            *(u32x2*)(lds + M_WS + p * 272 + q * 2) = wv; }
    }
    __syncthreads();
    {
        const int c8 = (tid & 15) * 8;
#pragma unroll
        for (int it = 0; it < 8; ++it) {
            const int q = (tid >> 4) + 32 * (it & 3), ch = it >> 2; const int cabs = g * 256 + ch * 128 + c8;
            const u32x4 raw = __builtin_nontemporal_load((const u32x4*)(P + (size_t)(T0 + q) * LDP + C_AV + cabs));
            const float mu = *(const float*)(lds + M_MU + q * 4), rs = *(const float*)(lds + M_RS + q * 4);
            const f32x4 g0 = *(const f32x4*)(c.a.ln_g + l * 2048 + cabs), g1 = *(const f32x4*)(c.a.ln_g + l * 2048 + cabs + 4);
            const f32x4 b0 = *(const f32x4*)(c.a.ln_b + l * 2048 + cabs), b1 = *(const f32x4*)(c.a.ln_b + l * 2048 + cabs + 4);
            float v[8] = {bflo(raw.x), bfhi(raw.x), bflo(raw.y), bfhi(raw.y), bflo(raw.z), bfhi(raw.z), bflo(raw.w), bfhi(raw.w)};
#pragma unroll
            for (int j = 0; j < 4; ++j) { v[j] = (v[j] - mu) * rs * g0[j] + b0[j]; v[4 + j] = (v[4 + j] - mu) * rs * g1[j] + b1[j]; }
            u32x4 wv; wv.x = cvt_pk_bf16(v[0], v[1]); wv.y = cvt_pk_bf16(v[2], v[3]); wv.z = cvt_pk_bf16(v[4], v[5]); wv.w = cvt_pk_bf16(v[6], v[7]);
            *(u32x4*)(lds + M_SV + (ch * 2 + (q >> 6)) * 16384 + att::v_st(q & 63, c8)) = wv;
        }
    }
    __syncthreads();
    const int pb = w & 3, ch = w >> 2, r32 = lane & 31, hi = lane >> 5;
    f32x16 o[4] = {};
#pragma unroll
    for (int qt = 0; qt < 2; ++qt) {
        bf16x8 pa[4];
#pragma unroll
        for (int ks = 0; ks < 4; ++ks) pa[ks] = *(const bf16x8*)(lds + M_WS + (32 * pb + r32) * 272 + (64 * qt + 16 * ks + 8 * hi) * 2);
        const int vb = (int)(uintptr_t)(lds + M_SV + (ch * 2 + qt) * 16384) + att::v_rd_base(lane);
        att::pv_d0(o, vb, pa[0], pa[1], pa[2], pa[3]);
    }
    __syncthreads();
    {
        float* slab = (float*)(lds + w * 16896);
#pragma unroll
        for (int r = 0; r < 16; ++r)
#pragma unroll
            for (int d0 = 0; d0 < 4; ++d0) slab[att::crow(r, hi) * 132 + 32 * d0 + r32] = o[d0][r];
#pragma unroll
        for (int it = 0; it < 8; ++it) {
            const int row = it * 4 + (lane >> 4), c8 = (lane & 15) * 8;
            const int p = 32 * pb + row; const size_t tok = (size_t)(T0 + p); const int cabs = g * 256 + ch * 128 + c8;
            const f32x4 x0 = *(const f32x4*)(slab + row * 132 + c8), x1 = *(const f32x4*)(slab + row * 132 + c8 + 4);
            const u32x4 ur = __builtin_nontemporal_load((const u32x4*)(P + tok * LDP + C_AU + cabs)), zr = __builtin_nontemporal_load((const u32x4*)(P + tok * LDP + C_AZ + cabs));
            const float bsv = c.a.gbs[(size_t)(l * 8 + g) * 128 + p];
            float v[8];
            v[0] = (x0[0] + bsv) * bflo(ur.x) * bflo(zr.x); v[1] = (x0[1] + bsv) * bfhi(ur.x) * bfhi(zr.x);
            v[2] = (x0[2] + bsv) * bflo(ur.y) * bflo(zr.y); v[3] = (x0[3] + bsv) * bfhi(ur.y) * bfhi(zr.y);
            v[4] = (x1[0] + bsv) * bflo(ur.z) * bflo(zr.z); v[5] = (x1[1] + bsv) * bfhi(ur.z) * bfhi(zr.z);
            v[6] = (x1[2] + bsv) * bflo(ur.w) * bflo(zr.w); v[7] = (x1[3] + bsv) * bfhi(ur.w) * bfhi(zr.w);
            u32x4 wv; wv.x = cvt_pk_bf16(v[0], v[1]); wv.y = cvt_pk_bf16(v[2], v[3]); wv.z = cvt_pk_bf16(v[4], v[5]); wv.w = cvt_pk_bf16(v[6], v[7]);
            __builtin_nontemporal_store(wv, (u32x4*)(br0 + tok * DM + cabs));
        }
    }
}

__device__ __forceinline__ void combine_phase(const Ctx& c, int l) {
    const bf16_t* P = (const bf16_t*)(c.a.ws + WS_P);
    const bf16_t* og = (const bf16_t*)(c.a.ws + WS_OG); const bf16_t* oa = (const bf16_t*)(c.a.ws + WS_OA);
    bf16_t* br1 = (bf16_t*)(c.a.ws + WS_BR) + (size_t)MT * DM; bf16_t* br2 = br1 + (size_t)MT * DM;
    const int lane = c.lane;
    const float* lv = c.a.dlam + l * 512;
    float s01 = lv[lane] * lv[128 + lane] + lv[64 + lane] * lv[192 + lane];
    float s23 = lv[256 + lane] * lv[384 + lane] + lv[320 + lane] * lv[448 + lane];
    s01 = wave_sum(s01); s23 = wave_sum(s23);
    const float lam_init = 0.8f - 0.6f * expf(-0.3f * (float)l);
    const float lam = expf(s01) - expf(s23) + lam_init;
    const float oml = 1.f - lam_init;
    const f32x4 gn0 = *(const f32x4*)(c.a.gla_norm + l * 512 + lane * 8), gn1 = *(const f32x4*)(c.a.gla_norm + l * 512 + lane * 8 + 4);
    const f32x4 dn0 = *(const f32x4*)(c.a.dnorm + l * 256 + (lane & 31) * 8), dn1 = *(const f32x4*)(c.a.dnorm + l * 256 + (lane & 31) * 8 + 4);
    const int nw = c.G * 8;
    for (int task = c.bx * 8 + c.wid; task < MT * 8; task += nw) {
        const int tok = task >> 3, sub = task & 7; const int col = (sub & 3) * 512 + lane * 8;
        if (sub < 4) {
            const u32x4 a = __builtin_nontemporal_load((const u32x4*)(og + (size_t)tok * DM + col)), bq = __builtin_nontemporal_load((const u32x4*)(og + (size_t)(MT + tok) * DM + col));
            const u32x4 zr = __builtin_nontemporal_load((const u32x4*)(P + (size_t)tok * LDP + C_BZ + col));
            float v[8] = {bflo(a.x) + bflo(bq.x), bfhi(a.x) + bfhi(bq.x), bflo(a.y) + bflo(bq.y), bfhi(a.y) + bfhi(bq.y),
                          bflo(a.z) + bflo(bq.z), bfhi(a.z) + bfhi(bq.z), bflo(a.w) + bflo(bq.w), bfhi(a.w) + bfhi(bq.w)};
            float ss = 0.f;
#pragma unroll
            for (int j = 0; j < 8; ++j) ss += v[j] * v[j];
            ss = wave_sum(ss); const float ri = rsqrtf(ss * (1.f / 512.f) + EPS);
            const float z[8] = {bflo(zr.x), bfhi(zr.x), bflo(zr.y), bfhi(zr.y), bflo(zr.z), bfhi(zr.z), bflo(zr.w), bfhi(zr.w)};
#pragma unroll
            for (int j = 0; j < 4; ++j) { v[j] = v[j] * ri * gn0[j] * z[j]; v[4 + j] = v[4 + j] * ri * gn1[j] * z[4 + j]; }
            u32x4 wv; wv.x = cvt_pk_bf16(v[0], v[1]); wv.y = cvt_pk_bf16(v[2], v[3]); wv.z = cvt_pk_bf16(v[4], v[5]); wv.w = cvt_pk_bf16(v[6], v[7]);
            __builtin_nontemporal_store(wv, (u32x4*)(br1 + (size_t)tok * DM + col));
        } else {
            const u32x4 a = __builtin_nontemporal_load((const u32x4*)(oa + (size_t)tok * DM + col)), bq = __builtin_nontemporal_load((const u32x4*)(oa + (size_t)(MT + tok) * DM + col));
            const u32x4 zr = __builtin_nontemporal_load((const u32x4*)(P + (size_t)tok * LDP + C_CZ + col));
            float v[8] = {bflo(a.x) - lam * bflo(bq.x), bfhi(a.x) - lam * bfhi(bq.x), bflo(a.y) - lam * bflo(bq.y), bfhi(a.y) - lam * bfhi(bq.y),
                          bflo(a.z) - lam * bflo(bq.z), bfhi(a.z) - lam * bfhi(bq.z), bflo(a.w) - lam * bflo(bq.w), bfhi(a.w) - lam * bfhi(bq.w)};
            float ss = 0.f;
#pragma unroll
            for (int j = 0; j < 8; ++j) ss += v[j] * v[j];
#pragma unroll
            for (int o = 16; o >= 1; o >>= 1) ss += __shfl_xor(ss, o);
            const float ri = rsqrtf(ss * (1.f / 256.f) + EPS) * oml;
            const float z[8] = {bflo(zr.x), bfhi(zr.x), bflo(zr.y), bfhi(zr.y), bflo(zr.z), bfhi(zr.z), bflo(zr.w), bfhi(zr.w)};
#pragma unroll
            for (int j = 0; j < 4; ++j) { v[j] = v[j] * ri * dn0[j] * z[j]; v[4 + j] = v[4 + j] * ri * dn1[j] * z[4 + j]; }
            u32x4 wv; wv.x = cvt_pk_bf16(v[0], v[1]); wv.y = cvt_pk_bf16(v[2], v[3]); wv.z = cvt_pk_bf16(v[4], v[5]); wv.w = cvt_pk_bf16(v[6], v[7]);
            __builtin_nontemporal_store(wv, (u32x4*)(br2 + (size_t)tok * DM + col));
        }
    }
}


#define XB_TMO      128
#define XB_XCNT(j)  (256  + 64 * (j))
#define XB_XSUB(j)  (1280 + 64 * (j))
#define XB_XGEN(j)  (2304 + 64 * (j))
#define XB_TOP      3328
#define XB_TOPGEN   3392
#define XCD_BAR_WORDS 3456
#define XB_SPIN_CAP (1u << 18)
__device__ __forceinline__ unsigned xb_ld(unsigned* p)              { return __hip_atomic_load(p, __ATOMIC_RELAXED, __HIP_MEMORY_SCOPE_AGENT); }
__device__ __forceinline__ unsigned xb_add(unsigned* p, unsigned v) { return __hip_atomic_fetch_add(p, v, __ATOMIC_RELAXED, __HIP_MEMORY_SCOPE_AGENT); }
__device__ __forceinline__ unsigned xb_xcc_id() { return (unsigned)__builtin_amdgcn_s_getreg((3 << 11) | 20) & 0xFu; }
#define XB_SPIN(cond, bar) do { unsigned _sp = 0; while (cond) { __builtin_amdgcn_s_sleep(1); \
    if ((++_sp & 255u) == 0u) { if (xb_ld(&(bar)[XB_TMO])) break; if (_sp > XB_SPIN_CAP) { atomicAdd(&(bar)[XB_TMO], 1u); break; } } } } while (0)
struct XcdBarrier { unsigned* bar; unsigned x; volatile LAS unsigned* st; };
__device__ __forceinline__ void xcd_barrier_complete(unsigned* bar, unsigned x, unsigned& nloc, unsigned& nx) {
    const unsigned G = gridDim.x * gridDim.y * gridDim.z;
    unsigned sum, cnt, mine, sp = 0u;
    for (;;) {
        sum = 0u; cnt = 0u; mine = 0u;
#pragma unroll
        for (unsigned j = 0; j < 16; ++j) { const unsigned c = xb_ld(&bar[XB_XCNT(j)]); sum += c; cnt += (c > 0u) ? 1u : 0u; mine = (j == x) ? c : mine; }
        if (sum == G) break;
        __builtin_amdgcn_s_sleep(1);
        if ((++sp & 255u) == 0u) { if (xb_ld(&bar[XB_TMO])) break; if (sp > XB_SPIN_CAP) { atomicAdd(&bar[XB_TMO], 1u); break; } }
    }
    nloc = mine > 0u ? mine : 1u; nx = cnt > 0u ? cnt : 1u;
}
__device__ __forceinline__ void xcd_barrier(const XcdBarrier& b, const bool t0) {
    asm volatile("s_waitcnt vmcnt(0)" ::: "memory");
    __syncthreads();
    if (t0) {
        unsigned* bar = b.bar;
        __builtin_amdgcn_s_waitcnt(0);
        unsigned nloc = b.st[0], nx = b.st[1];
        if (nloc == 0u) { xcd_barrier_complete(bar, b.x, nloc, nx); b.st[0] = nloc; b.st[1] = nx; }
        const unsigned old = xb_add(&bar[XB_XSUB(b.x)], 1u);
        const unsigned gen = old / nloc;
        if (old + 1u == (gen + 1u) * nloc) {
            __builtin_amdgcn_fence(__ATOMIC_RELEASE, "agent");
            asm volatile("s_waitcnt vmcnt(0)" ::: "memory");
            const unsigned og = xb_add(&bar[XB_TOP], 1u);
            const unsigned tg = og / nx;
            if (og + 1u == (tg + 1u) * nx) xb_add(&bar[XB_TOPGEN], 1u);
            else XB_SPIN(xb_ld(&bar[XB_TOPGEN]) == tg, bar);
            __builtin_amdgcn_fence(__ATOMIC_ACQUIRE, "agent");
            xb_add(&bar[XB_XGEN(b.x)], 1u);
            asm volatile("s_waitcnt vmcnt(0)" ::: "memory");
        } else {
            XB_SPIN(xb_ld(&bar[XB_XGEN(b.x)]) == gen, bar);
            __builtin_amdgcn_fence(__ATOMIC_ACQUIRE, "agent");
            asm volatile("s_waitcnt vmcnt(0)" ::: "memory");
        }
    }
    __syncthreads();
}

__global__ void __launch_bounds__(NTHR, 2) mk_fwd(Args a) {
    extern __shared__ __attribute__((aligned(16))) unsigned char shm[];
    Ctx c; c.a = a; c.lds = (char*)shm;
    const int wid_s = __builtin_amdgcn_readfirstlane((int)threadIdx.x >> 6);
    LAS unsigned char* ldsl = (LAS unsigned char*)shm;
    XcdBarrier xb;
    { volatile LAS unsigned* st = (volatile LAS unsigned*)(ldsl + 147456);
      const bool t0 = (wid_s == 0) && (__builtin_amdgcn_mbcnt_hi(~0u, __builtin_amdgcn_mbcnt_lo(~0u, 0u)) == 0u);
      if (t0) { st[0] = 0u; st[1] = 0u; }
      __syncthreads();
      xb.bar = (unsigned*)(a.ws + WS_BAR); xb.x = xb_xcc_id(); xb.st = st;
      if (t0) st[2] = xb_add(&xb.bar[XB_XCNT(xb.x)], 1u); }
    int vcu_x = -1;
    for (int ph = a.ph_lo; ph < a.ph_hi; ++ph) {
        if (ph > a.ph_lo) {
            if (ph == a.ph_lo + 1) {
                if (a.ph_hi > 1000) cg::this_grid().sync();
                xcd_barrier(xb, (wid_s == 0) && (__builtin_amdgcn_mbcnt_hi(~0u, __builtin_amdgcn_mbcnt_lo(~0u, 0u)) == 0u));
                volatile LAS unsigned* st = (volatile LAS unsigned*)(ldsl + 147456);
                if ((wid_s == 0) && (__builtin_amdgcn_mbcnt_hi(~0u, __builtin_amdgcn_mbcnt_lo(~0u, 0u)) == 0u)) {
                    unsigned pre = 0u, tot = 0u;
#pragma unroll
                    for (unsigned jx = 0; jx < 16; ++jx) { const unsigned cn = xb_ld(&xb.bar[XB_XCNT(jx)]); pre += (jx < xb.x) ? cn : 0u; tot += cn; }
                    st[3] = (tot == gridDim.x) ? pre + st[2] : blockIdx.x;
                }
                __syncthreads();
                vcu_x = __builtin_amdgcn_readfirstlane((int)st[3]);
            }
            else xcd_barrier(xb, (wid_s == 0) && (__builtin_amdgcn_mbcnt_hi(~0u, __builtin_amdgcn_mbcnt_lo(~0u, 0u)) == 0u));
        }
        { int vz = 0, sz = 0; asm volatile("" : "+v"(vz)); asm volatile("" : "+s"(sz));
          c.tid = wid_s * 64 + (int)__builtin_amdgcn_mbcnt_hi(~0u, __builtin_amdgcn_mbcnt_lo(~0u, 0u)) + vz; c.lane = c.tid & 63; c.wid = __builtin_amdgcn_readfirstlane(c.tid >> 6);
          { typedef __attribute__((address_space(1))) unsigned char gu8; gu8* wsp = (gu8*)a.ws; asm volatile("" : "+s"(wsp)); c.a.ws = (unsigned char*)wsp; }
          c.G = gridDim.x; c.bx = (int)blockIdx.x + sz; c.vcu = (vcu_x >= 0) ? vcu_x + sz : ((c.G % 8 == 0) ? (c.bx % 8) * (c.G / 8) + c.bx / 8 : c.bx); }
        unsigned char* const ws = c.a.ws;
        const int l = ph / 7, sp = ph % 7;
        if (ph == 14) { row_pass(c, 2, nullptr, a.norm_post + DM); continue; }
        if (sp == 0) {
            if (l == 0) { if (c.bx == 0) bias_table(c); row_pass(c, 0, a.norm_pre, nullptr); }
            else row_pass(c, 1, a.norm_pre + DM, a.norm_post);
            wconv_job(c, a.w_in + (size_t)l * 2048 * 20512, 20512, (bf16_t*)(ws + WS_W), N1, 1, 1);
        } else if (sp == 1) {
            pg8::Gemm g{(const bf16_t*)(ws + WS_H), (const bf16_t*)(ws + WS_W), MT, NP, DM};
            pg8::StaticOrder S; S.init(MT, NP, c.G, c.bx);
            pg8::Epi1 E{(bf16_t*)(ws + WS_P), (float*)(ws + WS_LR), (float*)(ws + WS_ST)};
#ifndef NO_G1
            pg8::gemm_phase<pg8::Epi1>(ldsl, g, S, E, c.tid);
#endif
        } else if (sp == 2) {
            for (int q = 0; ; ++q) {
                const int item = c.vcu + (q >> 3) * c.G; if (item >= 256) break;
                const int b = item >> 5, nb = item & 31, hd = q & 7;
                if (hd == 0) gla_lr_block(c, b, nb);
                gla_pre_item(c, l, b, hd >> 1, hd & 1, (hd & 1) ? 31 - nb : nb);
            }
        } else if (sp == 3) {
#ifndef NO_GLA
            for (int it = c.vcu; it < 256; it += c.G) gla_scan_item(c, l, it >> 5, (it >> 3) & 3, (it >> 2) & 1, it & 3);
#endif
#ifndef NO_ATT
            for (int it = c.vcu; it < 2048; it += c.G) attn2_item(c, it >> 8, (it >> 5) & 7, (it >> 4) & 1, it & 15);
#endif
#ifndef NO_GMLP
            for (int it = c.vcu; it < 1024; it += c.G) gmlp_item(c, l, it >> 7, (it >> 3) & 15, it & 7);
#endif
            __syncthreads();
            wconv_job(c, a.w_merge + (size_t)l * 2048 * 6144, 6144, (bf16_t*)(ws + WS_WM), 6144, 0, 1);
            wconv_job(c, a.w_branch + (size_t)(l * 3) * 2048 * 2048, 2048, (bf16_t*)(ws + WS_WB), 2048, 0, 3);
            wconv_job(c, a.w_out + (size_t)l * 2048 * 2048, 2048, (bf16_t*)(ws + WS_WO), 2048, 0, 1);
        } else if (sp == 4) {
            combine_phase(c, l);
        } else if (sp == 5) {
            pg8::StaticOrder S; S.init(MT, DM, c.G, c.bx);
            for (int i = 0; i < 3; ++i) {
                { pg8::Gemm g{(const bf16_t*)(ws + WS_H), (const bf16_t*)(ws + WS_WM) + (size_t)i * 2048 * 2048, MT, DM, DM};
                  pg8::EpiGate E{(bf16_t*)(ws + WS_GATE) + (size_t)i * MT * DM, a.b_merge + l * 6144 + i * 2048};
#ifndef NO_G4A
                  pg8::gemm_phase<pg8::EpiGate>(ldsl, g, S, E, c.tid);
#endif
 }
                { pg8::Gemm g{(const bf16_t*)(ws + WS_BR) + (size_t)i * MT * DM, (const bf16_t*)(ws + WS_WB) + (size_t)i * 2048 * 2048, MT, DM, DM};
                  pg8::EpiBranch E{(const bf16_t*)(ws + WS_GATE) + (size_t)i * MT * DM, (const bf16_t*)(ws + WS_MF) + (size_t)(i > 0 ? i - 1 : 0) * MT * DM, (i < 2) ? (bf16_t*)(ws + WS_MF) + (size_t)i * MT * DM : (bf16_t*)(ws + WS_MB), i};
#ifndef NO_G4B
                  pg8::gemm_phase<pg8::EpiBranch>(ldsl, g, S, E, c.tid);
#endif
 }
            }
        } else {
            pg8::Gemm g{(const bf16_t*)(ws + WS_MB), (const bf16_t*)(ws + WS_WO), MT, DM, DM};
            pg8::StaticOrder S; S.init(MT, DM, c.G, c.bx);
            pg8::EpiBf16Out E{(bf16_t*)(ws + WS_OUTF), DM};
#ifndef NO_G5
            pg8::gemm_phase<pg8::EpiBf16Out>(ldsl, g, S, E, c.tid);
#endif
        }
    }
}


#ifdef TESTK
__global__ void __launch_bounds__(NTHR, 2) tk(const bf16_t* A, const bf16_t* Bt, float* C) {
    extern __shared__ __attribute__((aligned(16))) unsigned char shm[];
    pg8::Gemm g{A, Bt, MT, DM, DM};
    pg8::StaticOrder S; S.init(MT, DM, gridDim.x, blockIdx.x);
    pg8::EpiF32 E{C, DM};
    pg8::gemm_phase<pg8::EpiF32>((LAS unsigned char*)shm, g, S, E, threadIdx.x);
}
#endif
extern "C" void kernel_launch(void* const* d_in, const int* in_sizes, int n_in, void* d_out, int out_size, void* d_ws, size_t ws_size, hipStream_t stream) {
    static int grid = 0;
    if (grid == 0) {
        if (n_in != 18 || out_size != MT * DM || ws_size < WS_END) { fprintf(stderr, "kernel_launch: unexpected shapes (n_in %d out %d ws %zu need %zu)\n", n_in, out_size, ws_size, (size_t)WS_END); grid = -1; return; }
        if (hipFuncSetAttribute((const void*)mk_fwd, hipFuncAttributeMaxDynamicSharedMemorySize, LDS_BYTES) != hipSuccess) { fprintf(stderr, "kernel_launch: hipFuncSetAttribute failed\n"); grid = -1; return; }
        int dev = 0, cus = 0, per_cu = 0;
        hipGetDevice(&dev); hipDeviceGetAttribute(&cus, hipDeviceAttributeMultiprocessorCount, dev);
        hipOccupancyMaxActiveBlocksPerMultiprocessor(&per_cu, (const void*)mk_fwd, NTHR, LDS_BYTES);
        (void)hipGetLastError();
        if (per_cu < 1) per_cu = 1;
        grid = cus;
    }
    if (grid < 0) return;
    (void)hipMemsetAsync((char*)d_ws + WS_BAR, 0, 16384, stream);
    Args a{};
    a.x = (const float*)d_in[0]; a.norm_pre = (const float*)d_in[1]; a.w_in = (const float*)d_in[2]; a.ln_g = (const float*)d_in[3]; a.ln_b = (const float*)d_in[4];
    a.gws = (const float*)d_in[5]; a.gbs = (const float*)d_in[6]; a.wa2 = (const float*)d_in[7]; a.ba = (const float*)d_in[8]; a.gla_norm = (const float*)d_in[9];
    a.dlam = (const float*)d_in[10]; a.dnorm = (const float*)d_in[11]; a.rel_bias = (const float*)d_in[12]; a.w_branch = (const float*)d_in[13]; a.w_merge = (const float*)d_in[14];
    a.b_merge = (const float*)d_in[15]; a.w_out = (const float*)d_in[16]; a.norm_post = (const float*)d_in[17];
    a.out = (float*)d_out; a.ws = (unsigned char*)d_ws;
#if MK_ONE_LAUNCH
    a.ph_lo = 0; a.ph_hi = 15;
    void* args[] = {&a};
    hipError_t e = hipLaunchCooperativeKernel((const void*)mk_fwd, dim3(grid), dim3(NTHR), args, LDS_BYTES, stream);
    if (e != hipSuccess) fprintf(stderr, "cooperative launch failed: %s (grid %d)\n", hipGetErrorString(e), grid);
#else
    for (int ph = 0; ph < 15; ++ph) {
        a.ph_lo = ph; a.ph_hi = ph + 1;
        hipLaunchKernelGGL(mk_fwd, dim3(grid), dim3(NTHR), LDS_BYTES, stream, a);
    }
#endif
}
```

```cpp
#include <hip/hip_runtime.h>
#include <hip/hip_cooperative_groups.h>
#include <cstdio>
#include <cstdint>
namespace cg = cooperative_groups;

#ifndef MK_ONE_LAUNCH
#define MK_ONE_LAUNCH 1
#endif

#define LAS __attribute__((address_space(3)))
typedef unsigned short bf16_t;
typedef short bf16x8 __attribute__((ext_vector_type(8)));
typedef short s16x4 __attribute__((ext_vector_type(4)));
typedef float f32x4 __attribute__((ext_vector_type(4)));
typedef float f32x2 __attribute__((ext_vector_type(2)));
typedef float f32x16 __attribute__((ext_vector_type(16)));
typedef unsigned u32x4 __attribute__((ext_vector_type(4)));
typedef unsigned u32x2 __attribute__((ext_vector_type(2)));

constexpr int MT = 16384, DM = 2048, SEQ = 2048;
constexpr int NP = 20480, LDP = 20480 + 64, N1 = 20736;
constexpr int C_AU = 0, C_AV = 2048, C_AZ = 4096, C_BQ = 6144, C_BK = 7168, C_BV = 8192, C_BZ = 10240, C_CQ = 12288, C_CK = 14336, C_CV = 16384, C_CZ = 18432;
constexpr float EPS = 1e-6f;
constexpr int NTHR = 512;
constexpr int LDS_BYTES = 147456 + 256;

constexpr size_t WS_W = 0;
constexpr size_t WS_WM = 0, WS_WB = 25165824, WS_WO = 50331648;
constexpr size_t WS_H = 84934656;
constexpr size_t WS_P = WS_H + 67108864;
constexpr size_t WS_GATE = WS_P, WS_MF = WS_P + 201326592, WS_MB = WS_P + 469762048, WS_OUTF = WS_P + 536870912;
constexpr size_t WS_LR = WS_P + (size_t)MT * LDP * 2;
constexpr size_t WS_ST = WS_LR + 2097152;
constexpr size_t WS_OG = WS_ST + 4194304;
constexpr size_t WS_OA = WS_OG + 134217728;
constexpr size_t WS_BR = WS_OA + 134217728;
constexpr size_t WS_TB = WS_BR + 201326592;
constexpr size_t WS_GQA = WS_BR + 67108864, WS_GKT = WS_BR + 134217728;
constexpr size_t WS_GSC = WS_TB + 16384, WS_GEC = WS_GSC + 16777216;
constexpr size_t WS_BAR = WS_GEC + 4194304;
constexpr size_t WS_END = WS_BAR + 16384;

struct Args {
    const float* x; const float* norm_pre; const float* w_in; const float* ln_g; const float* ln_b; const float* gws; const float* gbs;
    const float* wa2; const float* ba; const float* gla_norm; const float* dlam; const float* dnorm; const float* rel_bias;
    const float* w_branch; const float* w_merge; const float* b_merge; const float* w_out; const float* norm_post;
    float* out; unsigned char* ws; int ph_lo, ph_hi;
};

typedef __bf16 bf16x2_t __attribute__((ext_vector_type(2)));
__device__ __forceinline__ unsigned cvt_pk_bf16(float lo, float hi) { f32x2 v = {lo, hi}; bf16x2_t b = __builtin_convertvector(v, bf16x2_t); return __builtin_bit_cast(unsigned, b); }
__device__ __forceinline__ bf16_t f2bf(float f) { return (bf16_t)(cvt_pk_bf16(f, 0.f) & 0xffffu); }
__device__ __forceinline__ float bflo(unsigned u) { return __uint_as_float(u << 16); }
__device__ __forceinline__ float bfhi(unsigned u) { return __uint_as_float(u & 0xffff0000u); }
__device__ __forceinline__ float bf2f(bf16_t b) { return __uint_as_float(((unsigned)b) << 16); }
__device__ __forceinline__ float sigmoidf_(float x) { return __builtin_amdgcn_rcpf(1.f + __expf(-x)); }
__device__ __forceinline__ float siluf_(float x) { return x * sigmoidf_(x); }
__device__ __forceinline__ float gelu_tanh(float x) { const float y2 = 1.5957691216057308f * (x + 0.044715f * x * x * x); return x * sigmoidf_(y2); }
__device__ __forceinline__ float logsig(float z) { return fminf(z, 0.f) - __logf(1.f + __expf(-fabsf(z))); }
__device__ __forceinline__ float wave_sum(float v) {
#pragma unroll
    for (int o = 32; o >= 1; o >>= 1) v += __shfl_xor(v, o);
    return v;
}

namespace pg8 {
constexpr int BM = 256, BK = 64, HALF = 128, HTB = HALF * BK * 2, STAGE_BYTES = 8 * HTB, NXCD = 8, WGM = 8;
__host__ __device__ __forceinline__ int lds_byte(int r, int c) { const int st = (r >> 4) * 2 + (c >> 5), rr = r & 15, cc = c & 31, ob = rr * 64 + cc * 2; return st * 1024 + (ob ^ (((ob >> 9) & 1) << 5)); }
__host__ __device__ __forceinline__ void stage_rc(int b, int& R, int& C) { const int st = b / 1024, sb = b % 1024, swz = sb ^ (((sb >> 9) & 1) << 5); R = (st >> 1) * 16 + swz / 64; C = (st & 1) * 32 + (swz % 64) / 2; }
__host__ __device__ __forceinline__ int perm32(int rho) { const int n = rho >> 4, i = rho & 15; return 8 * (i >> 2) + 4 * n + (i & 3); }
struct Unit { int pm, pn; };
struct Gemm { const bf16_t* A; const bf16_t* Bt; int M, N, K; };
struct StaticOrder {
    int nM, nN, nwg, G, c;
    __device__ void init(int M, int N, int G_, int c_) { nM = M / BM; nN = N / BM; nwg = nM * nN; G = G_; c = c_; }
    __device__ bool next(int i, Unit& u) const {
        const long L = (long)i * G + c; if (L >= nwg) return false;
        int wgid = (int)L; { const int q = nwg / NXCD, r = nwg % NXCD, xcd = wgid % NXCD, off = wgid / NXCD; wgid = (xcd < r ? xcd * (q + 1) : r * (q + 1) + (xcd - r) * q) + off; }
        const int nig = WGM * nN, gid = wgid / nig, fm = gid * WGM, gsz = (nM - fm) < WGM ? (nM - fm) : WGM;
        u.pm = fm + ((wgid % nig) % gsz); u.pn = (wgid % nig) / gsz; return true;
    }
};

template <class Epi, bool ALIGN_EPI = true, bool SP2 = true>
__device__ __forceinline__ void gemm_phase(LAS unsigned char* lds, const Gemm g, const StaticOrder& S, const Epi& E, const int tid) {
    const int wid = __builtin_amdgcn_readfirstlane(tid >> 6), lane = tid & 63, wr = wid >> 2, wc = wid & 3, fr = lane & 15, fq = lane >> 4;
    const int K = g.K, nt = K / BK;
    unsigned voffA[2], voffB[2];
#pragma unroll
    for (int i = 0; i < 2; ++i) { int R, C; stage_rc(tid * 16 + i * 8192, R, C); const int Rb = Epi::PERM ? ((R & ~31) + perm32(R & 31)) : R;
        voffA[i] = (unsigned)(R * K + C) * 2u; voffB[i] = (unsigned)(Rb * K + C) * 2u; }
    const size_t kstep = (size_t)(BK * 2);
    const size_t hstep = (size_t)HALF * K * 2;
    const size_t tstep = 2 * hstep;
    const unsigned ldsw = (unsigned)wid * 1024u;
    const int aoff = lds_byte(wr * 64 + fr, fq * 8), boff = lds_byte(wc * 32 + fr, fq * 8);
#define PG8_SA(b, h) (((b) * 2 + (h)) * HTB)
#define PG8_SB(b, h) ((4 + (b) * 2 + (h)) * HTB)
#define PG8_STAGE(bufoff, gbase, voff) do { _Pragma("unroll") for (int _i = 0; _i < 2; ++_i) \
        __builtin_amdgcn_global_load_lds((const unsigned*)((const char*)(gbase) + (voff)[_i]), (LAS unsigned*)(lds + (bufoff) + ldsw + _i * 8192), 16, 0, 0); } while (0)
#define PG8_LDA(dst, b, h) do { _Pragma("unroll") for (int m = 0; m < 4; ++m) _Pragma("unroll") for (int k = 0; k < 2; ++k) dst[m][k] = *(const LAS bf16x8*)(lds + PG8_SA(b, h) + aoff + m * 2048 + k * 1024); } while (0)
#define PG8_LDB(dst, b, h) do { _Pragma("unroll") for (int n = 0; n < 2; ++n) _Pragma("unroll") for (int k = 0; k < 2; ++k) dst[n][k] = *(const LAS bf16x8*)(lds + PG8_SB(b, h) + boff + n * 2048 + k * 1024); } while (0)
#define PG8_MMA(ai, bj, At, Bt) do { __builtin_amdgcn_s_setprio(1); _Pragma("unroll") for (int m = 0; m < 4; ++m) _Pragma("unroll") for (int n = 0; n < 2; ++n) _Pragma("unroll") for (int k = 0; k < 2; ++k) \
        acc[ai][bj][m][n] = __builtin_amdgcn_mfma_f32_16x16x32_bf16(Bt[n][k], At[m][k], acc[ai][bj][m][n], 0, 0, 0); __builtin_amdgcn_s_setprio(0); } while (0)
#define PG8_WAIT_V(n) asm volatile("s_waitcnt vmcnt(" #n ")" ::: "memory")
#define PG8_WAIT_L(n) asm volatile("s_waitcnt lgkmcnt(" #n ")" ::: "memory")
#define PG8_BAR __builtin_amdgcn_s_barrier()
#define PG8_SCHED __builtin_amdgcn_sched_barrier(0)
    Unit cur, nxt; int ui = 0;
    if (!S.next(0, cur)) return;
    f32x4 acc[2][2][4][2];
#pragma unroll
    for (int a = 0; a < 2; ++a)
#pragma unroll
        for (int b = 0; b < 2; ++b)
#pragma unroll
            for (int m = 0; m < 4; ++m)
#pragma unroll
                for (int n = 0; n < 2; ++n) acc[a][b][m][n] = (f32x4){0.f, 0.f, 0.f, 0.f};
    bf16x8 At[4][2], B0[2][2], B1[2][2];
    const char* cA = (const char*)g.A + (size_t)cur.pm * tstep; const char* cB = (const char*)g.Bt + (size_t)cur.pn * tstep;
    if constexpr (SP2) {
        PG8_STAGE(PG8_SB(0, 0), cB, voffB); PG8_STAGE(PG8_SB(0, 1), cB + hstep, voffB); PG8_STAGE(PG8_SA(0, 0), cA, voffA); PG8_STAGE(PG8_SA(0, 1), cA + hstep, voffA);
        if (wr == 1) PG8_BAR;
        PG8_WAIT_V(2); PG8_BAR;
        PG8_STAGE(PG8_SB(1, 0), cB + kstep, voffB); PG8_STAGE(PG8_SA(1, 0), cA + kstep, voffA); PG8_STAGE(PG8_SB(1, 1), cB + hstep + kstep, voffB);
        PG8_WAIT_V(6); PG8_BAR;
    } else {
        PG8_STAGE(PG8_SB(0, 0), cB, voffB); PG8_STAGE(PG8_SA(0, 0), cA, voffA); PG8_STAGE(PG8_SB(0, 1), cB + hstep, voffB); PG8_STAGE(PG8_SA(0, 1), cA + hstep, voffA);
        if (wr == 1) PG8_BAR;
        PG8_WAIT_V(4); PG8_BAR;
        PG8_STAGE(PG8_SB(1, 0), cB + kstep, voffB); PG8_STAGE(PG8_SA(1, 0), cA + kstep, voffA); PG8_STAGE(PG8_SB(1, 1), cB + hstep + kstep, voffB);
        PG8_WAIT_V(6); PG8_BAR;
    }
    for (;;) {
        const bool has_next = S.next(ui + 1, nxt);
        const char* nA = has_next ? (const char*)g.A + (size_t)nxt.pm * tstep : cA; const char* nB = has_next ? (const char*)g.Bt + (size_t)nxt.pn * tstep : cB;
        for (int t = 0; t < nt; t += 2) {
            const bool last = (t == nt - 2);
            const char* a1 = cA + (size_t)(t + 1) * kstep;
            const char* a2 = last ? nA : cA + (size_t)(t + 2) * kstep; const char* b2 = last ? nB : cB + (size_t)(t + 2) * kstep;
            const char* a3 = a2 + kstep; const char* b3 = b2 + kstep;
            if constexpr (SP2) {
            PG8_LDB(B0, 0, 0); PG8_LDB(B1, 0, 1); PG8_SCHED; PG8_LDA(At, 0, 0); PG8_STAGE(PG8_SA(1, 1), a1 + hstep, voffA);
            PG8_WAIT_V(8); PG8_WAIT_L(0); PG8_BAR; PG8_MMA(0, 0, At, B0); PG8_MMA(0, 1, At, B1); PG8_BAR; PG8_SCHED;
            PG8_LDA(At, 0, 1); PG8_STAGE(PG8_SB(0, 0), b2, voffB); PG8_STAGE(PG8_SB(0, 1), b2 + hstep, voffB); PG8_STAGE(PG8_SA(0, 0), a2, voffA);
            PG8_WAIT_V(8); PG8_WAIT_L(0); PG8_BAR; PG8_MMA(1, 0, At, B0); PG8_MMA(1, 1, At, B1); PG8_BAR; PG8_SCHED;
            PG8_LDB(B0, 1, 0); PG8_LDB(B1, 1, 1); PG8_SCHED; PG8_LDA(At, 1, 0); PG8_STAGE(PG8_SA(0, 1), a2 + hstep, voffA);
            PG8_WAIT_V(8); PG8_WAIT_L(0); PG8_BAR; PG8_MMA(0, 0, At, B0); PG8_MMA(0, 1, At, B1); PG8_BAR; PG8_SCHED;
            PG8_LDA(At, 1, 1); PG8_STAGE(PG8_SB(1, 0), b3, voffB); PG8_STAGE(PG8_SB(1, 1), b3 + hstep, voffB); PG8_STAGE(PG8_SA(1, 0), a3, voffA);
            PG8_WAIT_V(8); PG8_WAIT_L(0); PG8_BAR; PG8_MMA(1, 0, At, B0); PG8_MMA(1, 1, At, B1); PG8_BAR; PG8_SCHED;
            } else {
            PG8_LDB(B0, 0, 0); PG8_SCHED; PG8_LDA(At, 0, 0); PG8_STAGE(PG8_SA(1, 1), a1 + hstep, voffA);
            PG8_WAIT_L(8); PG8_BAR; PG8_WAIT_L(0); PG8_MMA(0, 0, At, B0); PG8_BAR; PG8_SCHED;
            PG8_LDB(B1, 0, 1); PG8_STAGE(PG8_SB(0, 0), b2, voffB);
            PG8_BAR; PG8_WAIT_L(0); PG8_MMA(0, 1, At, B1); PG8_BAR;
            PG8_LDA(At, 0, 1); PG8_STAGE(PG8_SA(0, 0), a2, voffA);
            PG8_BAR; PG8_WAIT_L(0); PG8_MMA(1, 0, At, B0); PG8_BAR; PG8_SCHED;
            PG8_STAGE(PG8_SB(0, 1), b2 + hstep, voffB);
            PG8_WAIT_V(6); PG8_BAR; PG8_MMA(1, 1, At, B1); PG8_BAR;
            PG8_LDB(B0, 1, 0); PG8_SCHED; PG8_LDA(At, 1, 0); PG8_STAGE(PG8_SA(0, 1), a2 + hstep, voffA);
            PG8_WAIT_L(8); PG8_BAR; PG8_WAIT_L(0); PG8_MMA(0, 0, At, B0); PG8_BAR; PG8_SCHED;
            PG8_LDB(B1, 1, 1); PG8_STAGE(PG8_SB(1, 0), b3, voffB);
            PG8_BAR; PG8_WAIT_L(0); PG8_MMA(0, 1, At, B1); PG8_BAR;
            PG8_LDA(At, 1, 1); PG8_STAGE(PG8_SA(1, 0), a3, voffA);
            PG8_BAR; PG8_WAIT_L(0); PG8_MMA(1, 0, At, B0); PG8_BAR; PG8_SCHED;
            PG8_STAGE(PG8_SB(1, 1), b3 + hstep, voffB);
            PG8_WAIT_V(6); PG8_BAR; PG8_MMA(1, 1, At, B1); PG8_BAR;
            }
        }
        if constexpr (ALIGN_EPI) { if (wr == 0) PG8_BAR; }
        E(acc, cur, wr, wc, fr, fq);
        if (!has_next) break;
#pragma unroll
        for (int a = 0; a < 2; ++a)
#pragma unroll
            for (int b = 0; b < 2; ++b)
#pragma unroll
                for (int m = 0; m < 4; ++m)
#pragma unroll
                    for (int n = 0; n < 2; ++n) acc[a][b][m][n] = (f32x4){0.f, 0.f, 0.f, 0.f};
        cur = nxt; cA = nA; cB = nB; ++ui;
        if constexpr (ALIGN_EPI) { if (wr == 1) PG8_BAR; }
    }
    PG8_WAIT_V(0);
    if constexpr (!ALIGN_EPI) { if (wr == 0) PG8_BAR; }
    PG8_BAR;
#undef PG8_SA
#undef PG8_SB
#undef PG8_STAGE
#undef PG8_LDA
#undef PG8_LDB
#undef PG8_MMA
#undef PG8_WAIT_V
#undef PG8_WAIT_L
#undef PG8_BAR
#undef PG8_SCHED
}

struct EpiF32 {
    static constexpr bool PERM = false;
    float* C; int ldc;
    __device__ __forceinline__ void operator()(const f32x4 (&acc)[2][2][4][2], const Unit& u, int wr, int wc, int fr, int fq) const {
        const int row0 = u.pm * BM + wr * 64 + fr, col0 = u.pn * BM + wc * 32 + 4 * fq;
#pragma unroll
        for (int ai = 0; ai < 2; ++ai)
#pragma unroll
            for (int m = 0; m < 4; ++m) { float* rowp = C + (size_t)(row0 + ai * HALF + m * 16) * ldc + col0;
#pragma unroll
                for (int bj = 0; bj < 2; ++bj)
#pragma unroll
                    for (int n = 0; n < 2; ++n) *(f32x4*)(rowp + bj * HALF + n * 16) = acc[ai][bj][m][n]; }
    }
};
struct EpiBf16Out {
    static constexpr bool PERM = true;
    bf16_t* O; int ldc;
    __device__ __forceinline__ void operator()(const f32x4 (&acc)[2][2][4][2], const Unit& u, int wr, int wc, int fr, int fq) const {
        const int row0 = u.pm * BM + wr * 64 + fr; const int col0 = u.pn * BM + wc * 32 + 8 * fq;
#pragma unroll
        for (int ai = 0; ai < 2; ++ai)
#pragma unroll
            for (int m = 0; m < 4; ++m) { bf16_t* rowp = O + (size_t)(row0 + ai * HALF + m * 16) * ldc + col0;
#pragma unroll
                for (int bj = 0; bj < 2; ++bj) { const f32x4 v0 = acc[ai][bj][m][0], v1 = acc[ai][bj][m][1];
                    u32x4 w; w.x = cvt_pk_bf16(v0[0], v0[1]); w.y = cvt_pk_bf16(v0[2], v0[3]); w.z = cvt_pk_bf16(v1[0], v1[1]); w.w = cvt_pk_bf16(v1[2], v1[3]);
                    __builtin_nontemporal_store(w, (u32x4*)(rowp + bj * HALF)); } }
    }
};
struct Epi1 {
    static constexpr bool PERM = true;
    bf16_t* P; float* lr; float* stats;
    template <int KIND> __device__ __forceinline__ void run(const f32x4 (&acc)[2][2][4][2], const Unit& u, int wr, int wc, int fr, int fq, bool dost) const {
        const int row0 = u.pm * BM + wr * 64 + fr; const int col0 = u.pn * BM + wc * 32 + 8 * fq;
#pragma unroll
        for (int ai = 0; ai < 2; ++ai)
#pragma unroll
            for (int m = 0; m < 4; ++m) {
                const int row = row0 + ai * HALF + m * 16;
                bf16_t* rowp = P + (size_t)row * LDP + col0;
                float s = 0.f, q = 0.f;
#pragma unroll
                for (int bj = 0; bj < 2; ++bj) {
                    float v[8];
#pragma unroll
                    for (int j = 0; j < 4; ++j) { v[j] = acc[ai][bj][m][0][j]; v[4 + j] = acc[ai][bj][m][1][j]; }
#pragma unroll
                    for (int j = 0; j < 8; ++j) {
                        if (KIND == 1) v[j] = gelu_tanh(v[j]);
                        if (KIND == 2) v[j] = siluf_(v[j]);
                        if (KIND == 3) v[j] = v[j] * 0.0625f;
                    }
                    if (KIND == 1) {
#pragma unroll
                        for (int j = 0; j < 8; ++j) { s += v[j]; q += v[j] * v[j]; }
                    }
                    u32x4 w; w.x = cvt_pk_bf16(v[0], v[1]); w.y = cvt_pk_bf16(v[2], v[3]); w.z = cvt_pk_bf16(v[4], v[5]); w.w = cvt_pk_bf16(v[6], v[7]);
                    __builtin_nontemporal_store(w, (u32x4*)(rowp + bj * HALF));
                }
                if (KIND == 1) {
                    if (dost) {
                        s += __shfl_xor(s, 16); s += __shfl_xor(s, 32); q += __shfl_xor(q, 16); q += __shfl_xor(q, 32);
                        if (fq == 0) { *(f32x2*)(stats + ((size_t)row * 32 + (u.pn - 8) * 4 + wc) * 2) = (f32x2){s, q}; }
                    }
                }
            }
    }
    __device__ __forceinline__ void operator()(const f32x4 (&acc)[2][2][4][2], const Unit& u, int wr, int wc, int fr, int fq) const {
        const int pn = u.pn;
        if (pn == 80) {
            if (wc == 0) {
                const int row0 = u.pm * BM + wr * 64 + fr;
#pragma unroll
                for (int ai = 0; ai < 2; ++ai)
#pragma unroll
                    for (int m = 0; m < 4; ++m) { float* rp = lr + (size_t)(row0 + ai * HALF + m * 16) * 32 + 8 * fq;
                        *(f32x4*)(rp) = acc[ai][0][m][0]; *(f32x4*)(rp + 4) = acc[ai][0][m][1]; }
            }
            return;
        }
        if (pn < 16) run<1>(acc, u, wr, wc, fr, fq, pn >= 8);
        else if ((pn < 24) || (pn >= 40 && pn < 48) || (pn >= 72)) run<2>(acc, u, wr, wc, fr, fq, false);
        else if (pn < 28) run<3>(acc, u, wr, wc, fr, fq, false);
        else run<0>(acc, u, wr, wc, fr, fq, false);
    }
};
struct EpiGate {
    static constexpr bool PERM = true;
    bf16_t* G; const float* bias;
    __device__ __forceinline__ void operator()(const f32x4 (&acc)[2][2][4][2], const Unit& u, int wr, int wc, int fr, int fq) const {
        const int row0 = u.pm * BM + wr * 64 + fr; const int col0 = u.pn * BM + wc * 32 + 8 * fq;
        f32x4 bv[2][2];
#pragma unroll
        for (int bj = 0; bj < 2; ++bj)
#pragma unroll
            for (int n = 0; n < 2; ++n) bv[bj][n] = *(const f32x4*)(bias + col0 + bj * HALF + 4 * n);
#pragma unroll
        for (int ai = 0; ai < 2; ++ai)
#pragma unroll
            for (int m = 0; m < 4; ++m) { bf16_t* rowp = G + (size_t)(row0 + ai * HALF + m * 16) * DM + col0;
#pragma unroll
                for (int bj = 0; bj < 2; ++bj) { f32x4 v0 = acc[ai][bj][m][0] + bv[bj][0], v1 = acc[ai][bj][m][1] + bv[bj][1];
#pragma unroll
                    for (int j = 0; j < 4; ++j) { v0[j] = sigmoidf_(v0[j]); v1[j] = sigmoidf_(v1[j]); }
                    u32x4 w; w.x = cvt_pk_bf16(v0[0], v0[1]); w.y = cvt_pk_bf16(v0[2], v0[3]); w.z = cvt_pk_bf16(v1[0], v1[1]); w.w = cvt_pk_bf16(v1[2], v1[3]);
                    __builtin_nontemporal_store(w, (u32x4*)(rowp + bj * HALF)); } }
    }
};
struct EpiBranch {
    static constexpr bool PERM = true;
    const bf16_t* G; const bf16_t* mfi; bf16_t* mfo; int mode;
    __device__ __forceinline__ void operator()(const f32x4 (&acc)[2][2][4][2], const Unit& u, int wr, int wc, int fr, int fq) const {
        const int row0 = u.pm * BM + wr * 64 + fr; const int col0 = u.pn * BM + wc * 32 + 8 * fq;
#pragma unroll
        for (int ai = 0; ai < 2; ++ai)
#pragma unroll
            for (int m = 0; m < 4; ++m) { const size_t off = (size_t)(row0 + ai * HALF + m * 16) * DM + col0;
#pragma unroll
                for (int bj = 0; bj < 2; ++bj) { const size_t o2 = off + bj * HALF;
                    const u32x4 gw = __builtin_nontemporal_load((const u32x4*)(G + o2));
                    f32x4 v0 = acc[ai][bj][m][0], v1 = acc[ai][bj][m][1];
                    v0[0] *= bflo(gw.x); v0[1] *= bfhi(gw.x); v0[2] *= bflo(gw.y); v0[3] *= bfhi(gw.y);
                    v1[0] *= bflo(gw.z); v1[1] *= bfhi(gw.z); v1[2] *= bflo(gw.w); v1[3] *= bfhi(gw.w);
                    if (mode > 0) { const u32x4 pw = __builtin_nontemporal_load((const u32x4*)(mfi + o2));
                        v0[0] += bflo(pw.x); v0[1] += bfhi(pw.x); v0[2] += bflo(pw.y); v0[3] += bfhi(pw.y);
                        v1[0] += bflo(pw.z); v1[1] += bfhi(pw.z); v1[2] += bflo(pw.w); v1[3] += bfhi(pw.w); }
                    u32x4 w; w.x = cvt_pk_bf16(v0[0], v0[1]); w.y = cvt_pk_bf16(v0[2], v0[3]); w.z = cvt_pk_bf16(v1[0], v1[1]); w.w = cvt_pk_bf16(v1[2], v1[3]);
                    if (mode < 2) __builtin_nontemporal_store(w, (u32x4*)(mfo + o2)); else *(u32x4*)(mfo + o2) = w; } }
    }
};
}

#define LBAR() do { asm volatile("s_waitcnt lgkmcnt(0)" ::: "memory"); __builtin_amdgcn_s_barrier(); asm volatile("" ::: "memory"); } while (0)
namespace att {
constexpr int D = 128, NW = 8, QBLK = 32, KVBLK = 64;
constexpr float SCALE = 0.088388347648318440f;
constexpr float THR = 8.f;
#ifndef ATT_SDEPTH
#define ATT_SDEPTH 1
#endif
constexpr int SDEPTH = ATT_SDEPTH;
constexpr int LDQ = LDP, LDK = LDP, LDO = DM;
constexpr size_t SHM_V = KVBLK * D * 2, SHM_K = KVBLK * D * 2;
constexpr size_t TB_OFF = 2 * SHM_V + 2 * SHM_K + NW * 64 * 4;
constexpr size_t Q_OFF = TB_OFF + 2048;
#define KSWZ(row, colB) ((row) * 256 + ((colB) ^ (((row) & 7) << 4)))
#define SBAR() __builtin_amdgcn_sched_barrier(0)
__device__ __forceinline__ int crow(int r, int hi) { return (r & 3) + 8 * (r >> 2) + 4 * hi; }
__device__ __forceinline__ unsigned cvtpk(float lo, float hi) { return cvt_pk_bf16(lo, hi); }

__device__ __forceinline__ void partialSM(f32x16& p0, f32x16& p1, float& m_reg, float& mn, float& alpha) {
  constexpr float C = SCALE * 1.4426950408889634f;
  float pmax = p0[0]; for (int r = 1; r < 16; ++r) pmax = fmaxf(pmax, p0[r]); for (int r = 0; r < 16; ++r) pmax = fmaxf(pmax, p1[r]);
  { auto rr = __builtin_amdgcn_permlane32_swap(__float_as_uint(pmax), __float_as_uint(pmax), false, false);
    pmax = fmaxf(__uint_as_float(rr[0]), __uint_as_float(rr[1])); }
  if (__builtin_expect(__all(pmax - m_reg <= THR / SCALE), 1)) { mn = m_reg; alpha = 1.f; }
  else { mn = fmaxf(m_reg, pmax); alpha = __builtin_amdgcn_exp2f((m_reg - mn) * C); m_reg = mn; }
  float mnC = -mn * C;
  for (int r = 0; r < 16; ++r) p0[r] = fmaf(p0[r], C, mnC); for (int r = 0; r < 16; ++r) p1[r] = fmaf(p1[r], C, mnC);
  for (int r = 0; r < 16; ++r) p0[r] = __builtin_amdgcn_exp2f(p0[r]);
}
__device__ __forceinline__ void finishSM(f32x16& p0, f32x16& p1, float alpha, float& l_reg, bf16x8& pa0, bf16x8& pa1, bf16x8& pa2, bf16x8& pa3) {
  for (int r = 0; r < 16; ++r) p1[r] = __builtin_amdgcn_exp2f(p1[r]);
  float ps = 0; for (int r = 0; r < 16; ++r) ps += p0[r]; for (int r = 0; r < 16; ++r) ps += p1[r];
  { auto rr = __builtin_amdgcn_permlane32_swap(__float_as_uint(ps), __float_as_uint(ps), false, false);
    ps = __uint_as_float(rr[0]) + __uint_as_float(rr[1]); }
  l_reg = l_reg * alpha + ps;
#define PK4(P, BASE, OUT) do { unsigned a0 = cvtpk(P[BASE + 0], P[BASE + 1]), a1 = cvtpk(P[BASE + 2], P[BASE + 3]);   \
    unsigned b0 = cvtpk(P[BASE + 4], P[BASE + 5]), b1 = cvtpk(P[BASE + 6], P[BASE + 7]);                              \
    auto r0 = __builtin_amdgcn_permlane32_swap(a0, b0, false, false); auto r1 = __builtin_amdgcn_permlane32_swap(a1, b1, false, false); \
    u32x4 w = {r0[0], r1[0], r0[1], r1[1]}; OUT = *reinterpret_cast<bf16x8*>(&w); } while (0)
  PK4(p0, 0, pa0); PK4(p0, 8, pa1); PK4(p1, 0, pa2); PK4(p1, 8, pa3);
#undef PK4
}
__device__ __forceinline__ void qkt(f32x16& p0, f32x16& p1, const bf16_t* Ks, const char* Qs, int qrow, int r32, int hi, int relw, const float* tb_l, float cL, float cR) {
  const bool farL = (relw + 63 <= -91), farR = (relw - 31 >= 91);
  const float ini = farL ? cL : (farR ? cR : 0.f);
  for (int r = 0; r < 16; ++r) { p0[r] = ini; p1[r] = ini; }
  for (int d0 = 0; d0 < 8; ++d0) { int cb = (d0 * 16 + hi * 8) * 2;
    bf16x8 b0 = *reinterpret_cast<const bf16x8*>((const char*)Ks + KSWZ(r32, cb));
    bf16x8 b1 = *reinterpret_cast<const bf16x8*>((const char*)Ks + KSWZ(32 + r32, cb));
    const bf16x8 qv = *reinterpret_cast<const bf16x8*>(Qs + KSWZ(qrow, cb));
    p0 = __builtin_amdgcn_mfma_f32_32x32x16_bf16(b0, qv, p0, 0, 0, 0);
    p1 = __builtin_amdgcn_mfma_f32_32x32x16_bf16(b1, qv, p1, 0, 0, 0); }
  if (!(farL || farR)) {
    const int rel0 = relw - r32 + 128;
#pragma unroll
    for (int r = 0; r < 16; ++r) { int i0 = rel0 + crow(r, hi); int i1 = i0 + 32;
      i0 = min(max(i0, 0), 256); i1 = min(max(i1, 0), 256);
      p0[r] += tb_l[i0]; p1[r] += tb_l[i1]; }
  }
}
__device__ __forceinline__ int v_st(int k, int c) { const int kk = (k & ~0xC) | ((k & 4) << 1) | ((k & 8) >> 1); return ((kk >> 3) * 4 + (c >> 5)) * 512 + ((kk & 7) * 32 + (c & 31)) * 2; }
__device__ __forceinline__ int v_rd_base(int lane) { return ((lane & 3) << 3) | (((lane >> 2) & 3) << 6) | (((lane >> 4) & 1) << 5) | (((lane >> 5) & 1) << 8); }
constexpr int v_rd_off(int d0, int ks, int half) { return d0 * 512 + ks * 4096 + half * 2048; }
template <int OFF> __device__ __forceinline__ s16x4 tr_read(int vb) {
  s16x4 r; asm volatile("ds_read_b64_tr_b16 %0, %1 offset:%2" : "=&v"(r) : "v"(vb), "i"(OFF) : "memory"); return r;
}
template <int D0> __device__ __forceinline__ void pv_one(f32x16& od, int vb, bf16x8 pa0, bf16x8 pa1, bf16x8 pa2, bf16x8 pa3) {
  const s16x4 l0 = tr_read<v_rd_off(D0, 0, 0)>(vb), h0 = tr_read<v_rd_off(D0, 0, 1)>(vb), l1 = tr_read<v_rd_off(D0, 1, 0)>(vb), h1 = tr_read<v_rd_off(D0, 1, 1)>(vb);
  const s16x4 l2 = tr_read<v_rd_off(D0, 2, 0)>(vb), h2 = tr_read<v_rd_off(D0, 2, 1)>(vb), l3 = tr_read<v_rd_off(D0, 3, 0)>(vb), h3 = tr_read<v_rd_off(D0, 3, 1)>(vb);
  asm volatile("s_waitcnt lgkmcnt(0)" ::: "memory"); SBAR();
#define PK(L, H) (bf16x8){L[0], L[1], L[2], L[3], H[0], H[1], H[2], H[3]}
  od = __builtin_amdgcn_mfma_f32_32x32x16_bf16(pa0, PK(l0, h0), od, 0, 0, 0);
  od = __builtin_amdgcn_mfma_f32_32x32x16_bf16(pa1, PK(l1, h1), od, 0, 0, 0);
  od = __builtin_amdgcn_mfma_f32_32x32x16_bf16(pa2, PK(l2, h2), od, 0, 0, 0);
  od = __builtin_amdgcn_mfma_f32_32x32x16_bf16(pa3, PK(l3, h3), od, 0, 0, 0);
#undef PK
}
__device__ __forceinline__ void pv_d0(f32x16* o, int vb, bf16x8 pa0, bf16x8 pa1, bf16x8 pa2, bf16x8 pa3) {
  pv_one<0>(o[0], vb, pa0, pa1, pa2, pa3); pv_one<1>(o[1], vb, pa0, pa1, pa2, pa3); pv_one<2>(o[2], vb, pa0, pa1, pa2, pa3); pv_one<3>(o[3], vb, pa0, pa1, pa2, pa3);
}

__device__ __forceinline__ void attn_body(const bf16_t* __restrict__ Qb, const bf16_t* __restrict__ Kh, const bf16_t* __restrict__ Vh,
                                          bf16_t* __restrict__ Ob, int seq, char* lds, int q0, const float* __restrict__ tbg, const int tid) {
  const int wid = tid >> 6, lane = tid & 63, r32 = lane & 31, hi = lane >> 5;
  bf16_t* V_lds = (bf16_t*)lds; bf16_t* K_lds = (bf16_t*)(lds + 2 * SHM_V);
  float* ws = (float*)(lds + 2 * SHM_V + 2 * SHM_K) + wid * 64; float* li_l = ws; float* al_l = ws + 32;
  float* tb_l = (float*)(lds + TB_OFF);
  __syncthreads();
  if (tid < 257) tb_l[tid] = tbg[tid];
  const float cL = tbg[0], cR = tbg[256];
  const int q0w = q0 + wid * QBLK;
  float m_reg = -1e30f, l_reg = 0; f32x16 o[4] = {};
  const char* Qs = lds + Q_OFF + (wid >> 1) * 16384; const int qrow = (wid & 1) * 32 + r32;
  { const bf16_t* Qw = Qb + (long)(wid * QBLK + r32) * LDQ + hi * 8;
#pragma unroll
    for (int d0 = 0; d0 < 8; ++d0) { const bf16x8 t = *reinterpret_cast<const bf16x8*>(Qw + d0 * 16); *(bf16x8*)(const_cast<char*>(Qs) + KSWZ(qrow, (d0 * 16 + hi * 8) * 2)) = t; } }
  const int sr = tid >> 4, sc = (tid & 15) * 8, vst0 = v_st(sr, sc), vst1 = v_st(32 + sr, sc);
  const int vb0 = (int)(uintptr_t)V_lds + v_rd_base(lane);
  struct { bf16x8 vs0, vs1, ks0, ks1; } sr_[SDEPTH];
#define SLOAD(i, k0) do { sr_[i].vs0 = *(const bf16x8*)(&Vh[(long)((k0) + sr) * LDK + sc]); sr_[i].vs1 = *(const bf16x8*)(&Vh[(long)((k0) + 32 + sr) * LDK + sc]); \
    sr_[i].ks0 = *(const bf16x8*)(&Kh[(long)((k0) + sr) * LDK + sc]); sr_[i].ks1 = *(const bf16x8*)(&Kh[(long)((k0) + 32 + sr) * LDK + sc]); } while (0)
#define SWRITE(b, i) do { *(bf16x8*)((char*)V_lds + (b) * SHM_V + vst0) = sr_[i].vs0;          \
    *(bf16x8*)((char*)V_lds + (b) * SHM_V + vst1) = sr_[i].vs1; int kc = sc * 2;               \
    *(bf16x8*)((char*)K_lds + (b) * SHM_K + KSWZ(sr, kc)) = sr_[i].ks0;                       \
    *(bf16x8*)((char*)K_lds + (b) * SHM_K + KSWZ(32 + sr, kc)) = sr_[i].ks1; } while (0)
#define SWAIT() do { if constexpr (SDEPTH == 2) asm volatile("s_waitcnt vmcnt(4)" ::: "memory"); else asm volatile("s_waitcnt vmcnt(0)" ::: "memory"); } while (0)
#define RESC(a) do { if (__any((a) < 1.f)) { if (hi == 0) al_l[r32] = (a); asm volatile("s_waitcnt lgkmcnt(0)" ::: "memory"); \
    for (int d = 0; d < 4; ++d) for (int r = 0; r < 16; ++r) o[d][r] *= al_l[crow(r, hi)]; } } while (0)
  f32x16 pA0, pA1, pB0, pB1; float mnA, mnB, alA, alB; bf16x8 pa0, pa1, pa2, pa3; const int NT = seq / KVBLK;
  constexpr int SE = 0, SO = SDEPTH - 1;
  SLOAD(SE, 0); asm volatile("s_waitcnt vmcnt(0)" ::: "memory"); SWRITE(0, SE); __syncthreads();
  qkt(pA0, pA1, K_lds, Qs, qrow, r32, hi, 0 - q0w, tb_l, cL, cR); partialSM(pA0, pA1, m_reg, mnA, alA);
  SLOAD(SO, KVBLK); if constexpr (SDEPTH == 2) { if (2 < NT) SLOAD(SE, 2 * KVBLK); }
  SWAIT(); SWRITE(1, SO); __syncthreads();
  for (int j = 1; j + 1 < NT; j += 2) {
    SBAR(); qkt(pB0, pB1, (bf16_t*)((char*)K_lds + SHM_K), Qs, qrow, r32, hi, j * KVBLK - q0w, tb_l, cL, cR);
    SBAR(); SLOAD(SO, (j + SDEPTH) * KVBLK); SBAR();
    finishSM(pA0, pA1, alA, l_reg, pa0, pa1, pa2, pa3); SBAR();
    pv_d0(o, vb0, pa0, pa1, pa2, pa3); partialSM(pB0, pB1, m_reg, mnB, alB);
    LBAR(); SWAIT(); SWRITE(0, SE);
    RESC(alB); LBAR();
    SBAR(); qkt(pA0, pA1, K_lds, Qs, qrow, r32, hi, (j + 1) * KVBLK - q0w, tb_l, cL, cR);
    SBAR(); if (SDEPTH == 1 || j + 3 < NT) SLOAD(SE, (j + 1 + SDEPTH) * KVBLK); SBAR();
    finishSM(pB0, pB1, alB, l_reg, pa0, pa1, pa2, pa3); SBAR();
    pv_d0(o, vb0 + (int)SHM_V, pa0, pa1, pa2, pa3); partialSM(pA0, pA1, m_reg, mnA, alA);
    LBAR(); SWAIT(); SWRITE(1, SO);
    RESC(alA); LBAR();
  }
  SBAR(); qkt(pB0, pB1, (bf16_t*)((char*)K_lds + SHM_K), Qs, qrow, r32, hi, (NT - 1) * KVBLK - q0w, tb_l, cL, cR);
  finishSM(pA0, pA1, alA, l_reg, pa0, pa1, pa2, pa3); SBAR();
  pv_d0(o, vb0, pa0, pa1, pa2, pa3); partialSM(pB0, pB1, m_reg, mnB, alB);
  __syncthreads(); RESC(alB);
  finishSM(pB0, pB1, alB, l_reg, pa0, pa1, pa2, pa3); SBAR();
  pv_d0(o, vb0 + (int)SHM_V, pa0, pa1, pa2, pa3);
  if (hi == 0) li_l[r32] = l_reg; asm volatile("s_waitcnt lgkmcnt(0)" ::: "memory");
  float rli[16];
#pragma unroll
  for (int r = 0; r < 16; ++r) rli[r] = __builtin_amdgcn_rcpf(li_l[crow(r, hi)]);
  bf16_t* Ow = Ob + (long)(wid * QBLK) * LDO;
#pragma unroll
  for (int r = 0; r < 16; ++r) { int orow = crow(r, hi);
#pragma unroll
    for (int d0 = 0; d0 < 4; ++d0) Ow[(long)orow * LDO + d0 * 32 + r32] = f2bf(o[d0][r] * rli[r]); }
#undef SLOAD
#undef SWRITE
#undef SWAIT
#undef RESC
}
}

struct Ctx {
    Args a; char* lds; int tid, lane, wid, G, bx, vcu;
};

__device__ __forceinline__ int srccol(int nd, int mode) {
    if (mode == 0) return nd;
    return nd < 12288 ? nd : (nd < 20480 ? nd + 32 : (nd < 20512 ? nd - 20480 + 12288 : -1));
}
__device__ __forceinline__ void wconv_job(const Ctx& c, const float* __restrict__ src0, int ld, bf16_t* __restrict__ dst0, int nd, int mode, int nbatch) {
    float* tile = (float*)c.lds;
    int tz = 0; asm volatile("" : "+v"(tz));
    const int tid = c.tid + tz;
    const int ntn = nd / 256, ntb = ntn * 32, ntiles = ntb * nbatch;
    f32x4 v[8];
#define WC_LOAD(t) do { const int bi_ = (t) / ntb, tr_ = (t) - bi_ * ntb; const float* src = src0 + (size_t)bi_ * 2048 * ld; const int tn_ = tr_ % ntn, tk_ = tr_ / ntn; _Pragma("unroll") for (int it = 0; it < 8; ++it) { const int idx = it * NTHR + tid; const int kk = idx >> 6, nn4 = (idx & 63) * 4; \
        const int sc = srccol(tn_ * 256 + nn4, mode); v[it] = (f32x4){0.f, 0.f, 0.f, 0.f}; if (sc >= 0) v[it] = __builtin_nontemporal_load((const f32x4*)(src + (size_t)(tk_ * 64 + kk) * ld + sc)); } } while (0)
    int t = c.bx;
    if (t < ntiles) WC_LOAD(t);
    for (; t < ntiles; t += c.G) {
#pragma unroll
        for (int it = 0; it < 8; ++it) { const int idx = it * NTHR + tid; const int kk = idx >> 6, nn4 = (idx & 63) * 4; *(f32x4*)(tile + kk * 260 + nn4) = v[it]; }
        __syncthreads();
        if (t + c.G < ntiles) WC_LOAD(t + c.G);
        {
            const int bi = t / ntb, tr = t - bi * ntb; const int tn = tr % ntn, tk = tr / ntn;
            const int nn = tid >> 1, kh = tid & 1;
            bf16_t* dp = dst0 + (size_t)bi * nd * 2048 + (size_t)(tn * 256 + nn) * 2048 + tk * 64 + kh * 32;
#pragma unroll
            for (int q = 0; q < 4; ++q) {
                float x[8];
#pragma unroll
                for (int j = 0; j < 8; ++j) x[j] = tile[(kh * 32 + q * 8 + j) * 260 + nn];
                u32x4 w; w.x = cvt_pk_bf16(x[0], x[1]); w.y = cvt_pk_bf16(x[2], x[3]); w.z = cvt_pk_bf16(x[4], x[5]); w.w = cvt_pk_bf16(x[6], x[7]);
                *(u32x4*)(dp + q * 8) = w;
            }
        }
        __syncthreads();
    }
#undef WC_LOAD
}

__device__ __forceinline__ void row_pass(const Ctx& c, int mode, const float* gpre, const float* gpost) {
    const float* xin = (mode == 2) ? c.a.out : c.a.x;
    const bf16_t* outf = (const bf16_t*)(c.a.ws + WS_OUTF);
    bf16_t* H = (bf16_t*)(c.a.ws + WS_H);
    for (int row = c.bx * 8 + c.wid; row < MT; row += c.G * 8) {
        f32x4 xv[8];
        const size_t base = (size_t)row * DM;
#pragma unroll
        for (int it = 0; it < 8; ++it) xv[it] = __builtin_nontemporal_load((const f32x4*)(xin + base + it * 256 + c.lane * 4));
        if (mode != 0) {
            f32x4 ov[8]; float ss = 0.f;
#pragma unroll
            for (int it = 0; it < 8; ++it) { const u32x2 rw = __builtin_nontemporal_load((const u32x2*)(outf + base + it * 256 + c.lane * 4)); ov[it] = (f32x4){bflo(rw.x), bfhi(rw.x), bflo(rw.y), bfhi(rw.y)}; ss += ov[it][0] * ov[it][0] + ov[it][1] * ov[it][1] + ov[it][2] * ov[it][2] + ov[it][3] * ov[it][3]; }
            ss = wave_sum(ss); const float ri = rsqrtf(ss * (1.f / DM) + EPS);
#pragma unroll
            for (int it = 0; it < 8; ++it) { const f32x4 gp = *(const f32x4*)(gpost + it * 256 + c.lane * 4); xv[it] += ov[it] * ri * gp; __builtin_nontemporal_store(xv[it], (f32x4*)(c.a.out + base + it * 256 + c.lane * 4)); }
        }
        if (mode != 2) {
            float ss = 0.f;
#pragma unroll
            for (int it = 0; it < 8; ++it) ss += xv[it][0] * xv[it][0] + xv[it][1] * xv[it][1] + xv[it][2] * xv[it][2] + xv[it][3] * xv[it][3];
            ss = wave_sum(ss); const float ri = rsqrtf(ss * (1.f / DM) + EPS);
#pragma unroll
            for (int it = 0; it < 8; ++it) { const f32x4 g = *(const f32x4*)(gpre + it * 256 + c.lane * 4); const f32x4 hv = xv[it] * ri * g;
                u32x2 w; w.x = cvt_pk_bf16(hv[0], hv[1]); w.y = cvt_pk_bf16(hv[2], hv[3]); *(u32x2*)(H + base + it * 256 + c.lane * 4) = w; }
        }
    }
}

__device__ __forceinline__ void bias_table(const Ctx& c) {
    float* tb = (float*)(c.a.ws + WS_TB);
    for (int e = c.tid; e < 8 * 257; e += NTHR) {
        const int h = e / 257, idx = e % 257, rel = idx - 128;
        const int n = rel < 0 ? -rel : rel; const int ret = rel > 0 ? 16 : 0;
        const float nf = (float)(n > 1 ? n : 1);
        int large = 8 + (int)(logf(nf / 8.f) / 2.772588722239781f * 8.f);
        large = large < 15 ? large : 15;
        const int bucket = ret + (n < 8 ? n : large);
        tb[h * 260 + idx] = c.a.rel_bias[bucket * 8 + h] * (1.f / att::SCALE);
    }
}

constexpr int G_QA = 0, G_KB = 33792, G_KBT = 67584, G_VT = 104448, G_SC = 122880, G_LR = 132096, G_QS = 136192, G_ER = 140288, G_CC = 141312;
template <int OFF> __device__ __forceinline__ u32x4 lds_rd128(int addr) { u32x4 r; asm volatile("ds_read_b128 %0, %1 offset:%2" : "=&v"(r) : "v"(addr), "i"(OFF) : "memory"); return r; }
template <int OFF> __device__ __forceinline__ f32x4 lds_rdf(int addr) { f32x4 r; asm volatile("ds_read_b128 %0, %1 offset:%2" : "=&v"(r) : "v"(addr), "i"(OFF) : "memory"); return r; }
template <int OFF> __device__ __forceinline__ u32x2 lds_rd64(int addr) { u32x2 r; asm volatile("ds_read_b64 %0, %1 offset:%2" : "=&v"(r) : "v"(addr), "i"(OFF) : "memory"); return r; }
#define LWAIT() do { asm volatile("s_waitcnt lgkmcnt(0)" ::: "memory"); __builtin_amdgcn_sched_barrier(0); } while (0)
#define AS8(x) (*reinterpret_cast<const bf16x8*>(&(x)))
__device__ __forceinline__ bf16x8 pka_(u32x2 lo, u32x2 hi) { u32x4 w; w.x = lo.x; w.y = lo.y; w.z = hi.x; w.w = hi.y; return *reinterpret_cast<bf16x8*>(&w); }
#define PKA(l, h) pka_(l, h)
constexpr int A2_K0 = 0, A2_K1 = 17408, A2_V0 = 34816, A2_V1 = 71680, A2_TB = 108544;
__device__ __forceinline__ void attn2_item(const Ctx& c, int b, int h, int map, int qb) {
    char* lds = c.lds;
    const bf16_t* P = (const bf16_t*)(c.a.ws + WS_P);
    const bf16_t* Kh = P + (size_t)(b * SEQ) * LDP + C_CK + h * 256 + map * 128;
    const bf16_t* Vh = P + (size_t)(b * SEQ) * LDP + C_CV + h * 256;
    constexpr float SC = att::SCALE, C2 = att::SCALE * 1.4426950408889634f, THRR = att::THR / att::SCALE;
    int az = 0; asm volatile("" : "+v"(az));
    const int tid = c.tid + az, lane = tid & 63, w = c.wid, m16 = lane & 15, g4 = lane >> 4;
    const int q0w = qb * 128 + w * 16;
    float* tb_l = (float*)(lds + A2_TB);
    __syncthreads();
    if (tid < 257) {
        const int rel = tid - 128; const int n = rel < 0 ? -rel : rel; const int ret = rel > 0 ? 16 : 0;
        const float nf = (float)(n > 1 ? n : 1);
        int large = 8 + (int)(logf(nf / 8.f) / 2.772588722239781f * 8.f);
        large = large < 15 ? large : 15;
        const int bucket = ret + (n < 8 ? n : large);
        tb_l[tid] = c.a.rel_bias[bucket * 8 + h] * (1.f / SC);
    }
    const float cL = c.a.rel_bias[15 * 8 + h] * (1.f / SC), cR = c.a.rel_bias[31 * 8 + h] * (1.f / SC);
    bf16x8 qreg[4];
    {
        const bf16_t* Qw = P + (size_t)(b * SEQ + q0w + m16) * LDP + C_CQ + h * 256 + map * 128 + 8 * g4;
#pragma unroll
        for (int ks = 0; ks < 4; ++ks) qreg[ks] = *(const bf16x8*)(Qw + 32 * ks);
    }
    f32x4 o[16];
#pragma unroll
    for (int vt = 0; vt < 16; ++vt) o[vt] = (f32x4){0.f, 0.f, 0.f, 0.f};
    float m_reg = -1e30f, l_reg = 0.f;
    u32x4 sk[2][2]; unsigned sv[2][16];
#define A2_LOAD(sl, k0) do { _Pragma("unroll") for (int it = 0; it < 2; ++it) { const int v = it * NTHR + tid; sk[sl][it] = *(const u32x4*)(Kh + (size_t)((k0) + (v >> 4)) * LDP + (v & 15) * 8); } \
        _Pragma("unroll") for (int it = 0; it < 2; ++it) { const int u = it * NTHR + tid; const int cp = u & 127, kg = u >> 7; const bf16_t* vp = Vh + (size_t)((k0) + kg * 8) * LDP + 2 * cp; \
            _Pragma("unroll") for (int x = 0; x < 8; ++x) sv[sl][it * 8 + x] = *(const unsigned*)(vp + (size_t)x * LDP); } } while (0)
#define A2_LO2(x, y) __builtin_amdgcn_perm((y), (x), 0x05040100u)
#define A2_HI2(x, y) __builtin_amdgcn_perm((y), (x), 0x07060302u)
#define A2_WRITE(sl, buf) do { char* kb_ = lds + ((buf) ? A2_K1 : A2_K0); char* vb_ = lds + ((buf) ? A2_V1 : A2_V0); \
        _Pragma("unroll") for (int it = 0; it < 2; ++it) { const int v = it * NTHR + tid; *(u32x4*)(kb_ + (v >> 4) * 272 + (v & 15) * 16) = sk[sl][it]; } \
        _Pragma("unroll") for (int it = 0; it < 2; ++it) { const int u = it * NTHR + tid; const int cp = u & 127, kg = u >> 7; u32x4 a_, b_; \
            a_.x = A2_LO2(sv[sl][it * 8 + 0], sv[sl][it * 8 + 1]); a_.y = A2_LO2(sv[sl][it * 8 + 2], sv[sl][it * 8 + 3]); a_.z = A2_LO2(sv[sl][it * 8 + 4], sv[sl][it * 8 + 5]); a_.w = A2_LO2(sv[sl][it * 8 + 6], sv[sl][it * 8 + 7]); \
            b_.x = A2_HI2(sv[sl][it * 8 + 0], sv[sl][it * 8 + 1]); b_.y = A2_HI2(sv[sl][it * 8 + 2], sv[sl][it * 8 + 3]); b_.z = A2_HI2(sv[sl][it * 8 + 4], sv[sl][it * 8 + 5]); b_.w = A2_HI2(sv[sl][it * 8 + 6], sv[sl][it * 8 + 7]); \
            *(u32x4*)(vb_ + cp * 144 + kg * 16) = a_; *(u32x4*)(vb_ + (128 + cp) * 144 + kg * 16) = b_; } } while (0)
    A2_LOAD(0, 0);
    A2_WRITE(0, 0);
    LBAR();
    A2_LOAD(0, 64); A2_LOAD(1, 128);
    for (int j2 = 0; j2 < 32; j2 += 2) {
#pragma unroll
      for (int half = 0; half < 2; ++half) {
        const int j = j2 + half, buf = half;
        __builtin_amdgcn_sched_barrier(0);
        const int bK = (int)(uintptr_t)(lds + (buf ? A2_K1 : A2_K0)) + m16 * 272 + g4 * 16;
        const int bV = (int)(uintptr_t)(lds + (buf ? A2_V1 : A2_V0)) + m16 * 144 + g4 * 8;
        const int relw = j * 64 - q0w;
        const bool farL = (relw + 63 <= -91), farR = (relw - 15 >= 91);
        const float ini = farL ? cL : (farR ? cR : 0.f);
        f32x4 p[4];
#pragma unroll
        for (int kt = 0; kt < 4; ++kt) p[kt] = (f32x4){0.f, 0.f, 0.f, 0.f};
#define A2_KR(kt, ks) lds_rd128<(kt) * 4352 + (ks) * 64>(bK)
#define A2_MK(kt, ks, A) p[kt] = __builtin_amdgcn_mfma_f32_16x16x32_bf16(AS8(A), qreg[ks], p[kt], 0, 0, 0)
        {
            const u32x4 a00 = A2_KR(0, 0), a01 = A2_KR(0, 1), a02 = A2_KR(0, 2), a03 = A2_KR(0, 3), a10 = A2_KR(1, 0), a11 = A2_KR(1, 1), a12 = A2_KR(1, 2), a13 = A2_KR(1, 3);
            LWAIT();
            A2_MK(0, 0, a00); A2_MK(1, 0, a10); A2_MK(0, 1, a01); A2_MK(1, 1, a11); A2_MK(0, 2, a02); A2_MK(1, 2, a12); A2_MK(0, 3, a03); A2_MK(1, 3, a13);
        }
        {
            const u32x4 a20 = A2_KR(2, 0), a21 = A2_KR(2, 1), a22 = A2_KR(2, 2), a23 = A2_KR(2, 3), a30 = A2_KR(3, 0), a31 = A2_KR(3, 1), a32 = A2_KR(3, 2), a33 = A2_KR(3, 3);
            LWAIT();
            A2_MK(2, 0, a20); A2_MK(3, 0, a30); A2_MK(2, 1, a21); A2_MK(3, 1, a31); A2_MK(2, 2, a22); A2_MK(3, 2, a32); A2_MK(2, 3, a23); A2_MK(3, 3, a33);
        }
#undef A2_KR
#undef A2_MK
#define A2_VR(vt, kt) lds_rd64<(vt) * 2304 + (kt) * 32>(bV)
#define A2_VLOAD(P_, vt0) \
        const u32x2 P_##00 = A2_VR((vt0) + 0, 0), P_##01 = A2_VR((vt0) + 0, 1), P_##02 = A2_VR((vt0) + 0, 2), P_##03 = A2_VR((vt0) + 0, 3), P_##10 = A2_VR((vt0) + 1, 0), P_##11 = A2_VR((vt0) + 1, 1), P_##12 = A2_VR((vt0) + 1, 2), P_##13 = A2_VR((vt0) + 1, 3); \
        const u32x2 P_##20 = A2_VR((vt0) + 2, 0), P_##21 = A2_VR((vt0) + 2, 1), P_##22 = A2_VR((vt0) + 2, 2), P_##23 = A2_VR((vt0) + 2, 3), P_##30 = A2_VR((vt0) + 3, 0), P_##31 = A2_VR((vt0) + 3, 1), P_##32 = A2_VR((vt0) + 3, 2), P_##33 = A2_VR((vt0) + 3, 3);
#define A2_MV0(vt, X0, X1) o[vt] = __builtin_amdgcn_mfma_f32_16x16x32_bf16(PKA(X0, X1), AS8(bw0), o[vt], 0, 0, 0)
#define A2_MV1(vt, X2, X3) o[vt] = __builtin_amdgcn_mfma_f32_16x16x32_bf16(PKA(X2, X3), AS8(bw1), o[vt], 0, 0, 0)
#define A2_VMMA(P_, vt0) do { A2_MV0((vt0) + 0, P_##00, P_##01); A2_MV0((vt0) + 1, P_##10, P_##11); A2_MV0((vt0) + 2, P_##20, P_##21); A2_MV0((vt0) + 3, P_##30, P_##31); \
        A2_MV1((vt0) + 0, P_##02, P_##03); A2_MV1((vt0) + 1, P_##12, P_##13); A2_MV1((vt0) + 2, P_##22, P_##23); A2_MV1((vt0) + 3, P_##32, P_##33); } while (0)
        A2_VLOAD(va, 0)
        if (!(farL || farR)) {
            const int rel0 = relw - m16 + 4 * g4 + 128;
#pragma unroll
            for (int kt = 0; kt < 4; ++kt)
#pragma unroll
                for (int r = 0; r < 4; ++r) { int ix = rel0 + 16 * kt + r; ix = min(max(ix, 0), 256); p[kt][r] += tb_l[ix]; }
        }
        float pmax = p[0][0];
#pragma unroll
        for (int kt = 0; kt < 4; ++kt)
#pragma unroll
            for (int r = 0; r < 4; ++r) pmax = fmaxf(pmax, p[kt][r]);
        { auto rr = __builtin_amdgcn_permlane16_swap(__float_as_uint(pmax), __float_as_uint(pmax), false, false); pmax = fmaxf(__uint_as_float(rr[0]), __uint_as_float(rr[1])); }
        { auto rr = __builtin_amdgcn_permlane32_swap(__float_as_uint(pmax), __float_as_uint(pmax), false, false); pmax = fmaxf(__uint_as_float(rr[0]), __uint_as_float(rr[1])); }
        pmax += ini;
        if (!__all(pmax - m_reg <= THRR)) {
            const float mn = fmaxf(m_reg, pmax); const float alpha = __builtin_amdgcn_exp2f((m_reg - mn) * C2); m_reg = mn;
            l_reg *= alpha;
#pragma unroll
            for (int vt = 0; vt < 16; ++vt) o[vt] *= alpha;
        }
        const float mnC = (ini - m_reg) * C2; float ps = 0.f;
#pragma unroll
        for (int kt = 0; kt < 4; ++kt)
#pragma unroll
            for (int r = 0; r < 4; ++r) { const float e = __builtin_amdgcn_exp2f(fmaf(p[kt][r], C2, mnC)); p[kt][r] = e; ps += e; }
        l_reg += ps;
        u32x4 bw0, bw1;
        bw0.x = cvt_pk_bf16(p[0][0], p[0][1]); bw0.y = cvt_pk_bf16(p[0][2], p[0][3]); bw0.z = cvt_pk_bf16(p[1][0], p[1][1]); bw0.w = cvt_pk_bf16(p[1][2], p[1][3]);
        bw1.x = cvt_pk_bf16(p[2][0], p[2][1]); bw1.y = cvt_pk_bf16(p[2][2], p[2][3]); bw1.z = cvt_pk_bf16(p[3][0], p[3][1]); bw1.w = cvt_pk_bf16(p[3][2], p[3][3]);
        LWAIT();
        A2_VMMA(va, 0);
        { A2_VLOAD(vb, 4) LWAIT(); A2_VMMA(vb, 4); }
        { A2_VLOAD(vc, 8) LWAIT(); A2_VMMA(vc, 8); }
        { A2_VLOAD(vd, 12) LWAIT(); A2_VMMA(vd, 12); }
#undef A2_VR
#undef A2_VLOAD
#undef A2_MV0
#undef A2_MV1
#undef A2_VMMA
        __builtin_amdgcn_sched_barrier(0);
        A2_WRITE(half, buf ^ 1);
        LBAR();
        { const int jn = (j + 3 < 32) ? j + 3 : 31; A2_LOAD(half, jn * 64); }
      }
    }
    l_reg += __shfl_xor(l_reg, 16); l_reg += __shfl_xor(l_reg, 32);
    const float rl = __builtin_amdgcn_rcpf(l_reg);
    bf16_t* Ob = (bf16_t*)(c.a.ws + WS_OA) + ((size_t)map * MT + b * SEQ + q0w + m16) * DM + h * 256 + 8 * g4;
#pragma unroll
    for (int vt = 0; vt < 8; ++vt) {
        u32x4 wv; wv.x = cvt_pk_bf16(o[vt][0] * rl, o[vt + 8][0] * rl); wv.y = cvt_pk_bf16(o[vt][1] * rl, o[vt + 8][1] * rl);
        wv.z = cvt_pk_bf16(o[vt][2] * rl, o[vt + 8][2] * rl); wv.w = cvt_pk_bf16(o[vt][3] * rl, o[vt + 8][3] * rl);
        __builtin_nontemporal_store(wv, (u32x4*)(Ob + 32 * vt));
    }
#undef A2_LOAD
#undef A2_WRITE
#undef A2_LO2
#undef A2_HI2
}

#define OPQ(v) ({ int _z = 0; asm volatile("" : "+v"(_z)); (v) + _z; })
#define GROW(nn, i) (b * SEQ + (dir ? (SEQ - 1 - ((nn) * 64 + (i))) : ((nn) * 64 + (i))))
__device__ __forceinline__ void gla_lr_block(const Ctx& c, int b, int nb) {
    char* lds = c.lds;
    const bf16_t* H = (const bf16_t*)(c.a.ws + WS_H) + (size_t)(b * SEQ + nb * 64) * DM;
    const bf16_t* WL = (const bf16_t*)(c.a.ws + WS_W) + (size_t)20480 * DM;
    const int w = c.wid; const int ln = OPQ(c.lane); const int m16 = ln & 15, g4 = ln >> 4;
    f32x4 acc[4][2];
#pragma unroll
    for (int rt = 0; rt < 4; ++rt) { acc[rt][0] = (f32x4){0.f, 0.f, 0.f, 0.f}; acc[rt][1] = (f32x4){0.f, 0.f, 0.f, 0.f}; }
#pragma unroll 2
    for (int ks = 0; ks < 8; ++ks) {
        const int k0 = 256 * w + 32 * ks + 8 * g4;
        const bf16x8 b0 = *(const bf16x8*)(WL + (size_t)m16 * DM + k0), b1 = *(const bf16x8*)(WL + (size_t)(16 + m16) * DM + k0);
#pragma unroll
        for (int rt = 0; rt < 4; ++rt) {
            const bf16x8 av = *(const bf16x8*)(H + (size_t)(rt * 16 + m16) * DM + k0);
            acc[rt][0] = __builtin_amdgcn_mfma_f32_16x16x32_bf16(av, b0, acc[rt][0], 0, 0, 0);
            acc[rt][1] = __builtin_amdgcn_mfma_f32_16x16x32_bf16(av, b1, acc[rt][1], 0, 0, 0);
        }
    }
    LBAR();
#pragma unroll
    for (int rt = 0; rt < 4; ++rt)
#pragma unroll
        for (int ct = 0; ct < 2; ++ct)
#pragma unroll
            for (int r = 0; r < 4; ++r) *(float*)(lds + G_QA + ((w * 64 + rt * 16 + 4 * g4 + r) * 32 + ct * 16 + m16) * 4) = acc[rt][ct][r];
    LBAR();
    {
        const int tc = OPQ(c.tid);
        f32x4 sacc = (f32x4){0.f, 0.f, 0.f, 0.f};
#pragma unroll
        for (int w2 = 0; w2 < 8; ++w2) sacc += *(const f32x4*)(lds + G_QA + (w2 * 2048 + tc * 4) * 4);
        *(f32x4*)(lds + G_VT + tc * 16) = sacc;
    }
    LBAR();
}

__device__ __forceinline__ void gla_pre_item(const Ctx& c, int l, int b, int h, int dir, int n) {
    char* lds = c.lds;
    const bf16_t* P = (const bf16_t*)(c.a.ws + WS_P);
    const int ci = ((b * 4 + h) * 2 + dir) * 32 + n;
    const int w = c.wid;
    const int te = OPQ(c.tid); const int dp = te & 127, qr = te >> 7;
    const int rstep = dir ? -LDP : LDP;
    unsigned rq[16], rk[16];
    {
        const bf16_t* Pn = P + (size_t)GROW(n, 0) * LDP; const int t0 = (C_BQ + h * 256 + 2 * dp) + 16 * qr * rstep;
#pragma unroll
        for (int i = 0; i < 16; ++i) { rq[i] = *(const unsigned*)(Pn + (t0 + i * rstep)); rk[i] = *(const unsigned*)(Pn + (t0 + i * rstep + (C_BK - C_BQ))); }
    }
    float wa0[16], wa1[16];
    {
        const float* wp = c.a.wa2 + ((size_t)(l * 2 + dir) * 16) * 1024 + h * 256 + 2 * dp;
#pragma unroll
        for (int r = 0; r < 16; ++r) { const f32x2 t = *(const f32x2*)(wp + r * 1024); wa0[r] = t.x; wa1[r] = t.y; }
    }
    const f32x2 bav = *(const f32x2*)(c.a.ba + (size_t)(l * 2 + dir) * 1024 + h * 256 + 2 * dp);
    LBAR();
    float cl0[16], cl1[16];
    {
        float run0 = 0.f, run1 = 0.f;
#pragma unroll
        for (int i = 0; i < 16; ++i) {
            const int ii = dir ? (63 - (16 * qr + i)) : (16 * qr + i);
            const float* lp = (const float*)(lds + G_VT) + ii * 32 + dir * 16;
            float z0 = bav.x, z1 = bav.y;
#pragma unroll
            for (int r4 = 0; r4 < 4; ++r4) { const f32x4 t = *(const f32x4*)(lp + 4 * r4);
#pragma unroll
                for (int j = 0; j < 4; ++j) { z0 = fmaf(t[j], wa0[4 * r4 + j], z0); z1 = fmaf(t[j], wa1[4 * r4 + j], z1); } }
            run0 += logsig(z0) * 0.0625f; run1 += logsig(z1) * 0.0625f; cl0[i] = run0; cl1[i] = run1;
        }
        *(f32x2*)(lds + G_QS + (qr * 256 + 2 * dp) * 4) = (f32x2){run0, run1};
    }
    LBAR();
    {
        const f32x2 s0 = *(const f32x2*)(lds + G_QS + (0 * 256 + 2 * dp) * 4), s1 = *(const f32x2*)(lds + G_QS + (1 * 256 + 2 * dp) * 4);
        const f32x2 s2 = *(const f32x2*)(lds + G_QS + (2 * 256 + 2 * dp) * 4), s3 = *(const f32x2*)(lds + G_QS + (3 * 256 + 2 * dp) * 4);
        const f32x2 ref = s0 + s1, last = ref + s2 + s3;
        f32x2 pre = (f32x2){0.f, 0.f};
        if (qr > 0) pre += s0; if (qr > 1) pre += s1; if (qr > 2) pre += s2;
#define LO2(x, y) (((x) & 0xffffu) | ((y) << 16))
#define HI2(x, y) (((x) >> 16) | ((y) & 0xffff0000u))
        const float er0 = __expf(ref.x), er1 = __expf(ref.y), cc0 = __expf(last.x - ref.x), cc1 = __expf(last.y - ref.y);
        unsigned char* gq = c.a.ws + WS_GQA + (size_t)ci * 32768; unsigned char* gk = c.a.ws + WS_GKT + (size_t)ci * 32768;
#pragma unroll
        for (int hf = 0; hf < 2; ++hf) {
            unsigned ks[8];
#pragma unroll
            for (int ii = 0; ii < 8; ++ii) {
                const int i = hf * 8 + ii;
                const float c0 = cl0[i] + pre.x, c1 = cl1[i] + pre.y;
                const float ea0 = __expf(c0 - ref.x), ea1 = __expf(c1 - ref.y), eb0 = __expf(ref.x - c0), eb1 = __expf(ref.y - c1);
                const float qa0 = bflo(rq[i]) * ea0, qa1 = bfhi(rq[i]) * ea1, kb0 = bflo(rk[i]) * eb0, kb1 = bfhi(rk[i]) * eb1;
                *(unsigned*)(lds + G_QA + (16 * qr + i) * 528 + dp * 4) = cvt_pk_bf16(qa0, qa1);
                *(unsigned*)(lds + G_KB + (16 * qr + i) * 528 + dp * 4) = cvt_pk_bf16(kb0, kb1);
                *(unsigned*)(gq + ((16 * qr + i) * 256 + 2 * dp) * 2) = cvt_pk_bf16(qa0 * er0, qa1 * er1);
                ks[ii] = cvt_pk_bf16(kb0 * cc0, kb1 * cc1);
            }
            u32x4 a0, b0;
            a0.x = LO2(ks[0], ks[1]); a0.y = LO2(ks[2], ks[3]); a0.z = LO2(ks[4], ks[5]); a0.w = LO2(ks[6], ks[7]);
            b0.x = HI2(ks[0], ks[1]); b0.y = HI2(ks[2], ks[3]); b0.z = HI2(ks[4], ks[5]); b0.w = HI2(ks[6], ks[7]);
            *(u32x4*)(gk + ((2 * dp) * 64 + 16 * qr + hf * 8) * 2) = a0;
            *(u32x4*)(gk + ((2 * dp + 1) * 64 + 16 * qr + hf * 8) * 2) = b0;
        }
#undef LO2
#undef HI2
        if (qr == 0) *(f32x2*)(lds + G_ER + 2 * dp * 4) = (f32x2){__expf(last.x), __expf(last.y)};
    }
    LBAR();
    {
        const int ln5 = OPQ(c.lane); const int m16 = ln5 & 15, g4 = ln5 >> 4;
#pragma unroll
        for (int s = 0; s < 2; ++s) {
            const int idx = 2 * w + s, ti = idx >> 2, tj = idx & 3;
            f32x4 cc = (f32x4){0.f, 0.f, 0.f, 0.f};
            if (tj <= ti) {
#pragma unroll
                for (int ks = 0; ks < 8; ++ks) {
                    const bf16x8 av = *(const bf16x8*)(lds + G_QA + (16 * ti + m16) * 528 + (32 * ks + 8 * g4) * 2);
                    const bf16x8 bv = *(const bf16x8*)(lds + G_KB + (16 * tj + m16) * 528 + (32 * ks + 8 * g4) * 2);
                    cc = __builtin_amdgcn_mfma_f32_16x16x32_bf16(av, bv, cc, 0, 0, 0);
                }
                if (ti == tj) {
#pragma unroll
                    for (int r = 0; r < 4; ++r) if (m16 > 4 * g4 + r) cc[r] = 0.f;
                }
            }
#pragma unroll
            for (int r = 0; r < 4; ++r) *(bf16_t*)(lds + G_SC + (16 * ti + 4 * g4 + r) * 144 + (16 * tj + m16) * 2) = f2bf(cc[r]);
        }
    }
    LBAR();
    {
        const int tc = OPQ(c.tid);
        *(u32x4*)(c.a.ws + WS_GSC + (size_t)ci * 8192 + tc * 16) = *(const u32x4*)(lds + G_SC + (tc >> 3) * 144 + (tc & 7) * 16);
        if (tc < 64) *(u32x4*)(c.a.ws + WS_GEC + (size_t)ci * 2048 + tc * 16) = *(const u32x4*)(lds + G_ER + tc * 16);
    }
}

__device__ __forceinline__ void gla_scan_item(const Ctx& c, int l, int b, int h, int dir, int dvs) {
    char* lds = c.lds;
    const bf16_t* P = (const bf16_t*)(c.a.ws + WS_P);
    bf16_t* og = (bf16_t*)(c.a.ws + WS_OG) + (size_t)dir * MT * DM;
    const int w = c.wid;
    const int ci0 = ((b * 4 + h) * 2 + dir) * 32;
    const int rstep = dir ? -LDP : LDP;
    f32x4 S[16];
#pragma unroll
    for (int t = 0; t < 16; ++t) S[t] = (f32x4){0.f, 0.f, 0.f, 0.f};
    u32x4 pq[4], pk[4], ps, pe; unsigned rv[8];
#define GS_LOAD(nn, tz) do { const int tc = c.tid + (tz); const size_t ci = (size_t)(ci0 + (nn)); \
        const unsigned char* gq = c.a.ws + WS_GQA + ci * 32768; const unsigned char* gk = c.a.ws + WS_GKT + ci * 32768; \
        _Pragma("unroll") for (int it = 0; it < 4; ++it) { pq[it] = *(const u32x4*)(gq + (it * NTHR + tc) * 16); pk[it] = *(const u32x4*)(gk + (it * NTHR + tc) * 16); } \
        ps = *(const u32x4*)(c.a.ws + WS_GSC + ci * 8192 + tc * 16); \
        pe = *(const u32x4*)(c.a.ws + WS_GEC + ci * 2048 + (tc & 63) * 16); \
        { const int ep = tc & 63, q8 = tc >> 6; const bf16_t* Pn = P + (size_t)GROW(nn, 0) * LDP; const int t0 = (C_BV + h * 512 + dvs * 128 + 2 * ep) + 8 * q8 * rstep; \
          _Pragma("unroll") for (int x = 0; x < 8; ++x) rv[x] = *(const unsigned*)(Pn + (t0 + x * rstep)); } } while (0)
    { int tz = 0; asm volatile("" : "+v"(tz)); GS_LOAD(0, tz); }
    for (int n = 0; n < 32; ++n) {
        int oz = 0; asm volatile("" : "+v"(oz));
        const int tc = c.tid + oz;
        LBAR();
        {
#pragma unroll
            for (int it = 0; it < 4; ++it) { const int v = it * NTHR + tc;
                *(u32x4*)(lds + G_QA + (v >> 5) * 528 + (v & 31) * 16) = pq[it];
                *(u32x4*)(lds + G_KBT + (v >> 3) * 144 + (v & 7) * 16) = pk[it]; }
            *(u32x4*)(lds + G_SC + (tc >> 3) * 144 + (tc & 7) * 16) = ps;
            if (tc < 64) *(u32x4*)(lds + G_ER + tc * 16) = pe;
            const int ep = tc & 63, q8 = tc >> 6;
#define LO2(x, y) (((x) & 0xffffu) | ((y) << 16))
#define HI2(x, y) (((x) >> 16) | ((y) & 0xffff0000u))
            u32x4 v0, v1;
            v0.x = LO2(rv[0], rv[1]); v0.y = LO2(rv[2], rv[3]); v0.z = LO2(rv[4], rv[5]); v0.w = LO2(rv[6], rv[7]);
            v1.x = HI2(rv[0], rv[1]); v1.y = HI2(rv[2], rv[3]); v1.z = HI2(rv[4], rv[5]); v1.w = HI2(rv[6], rv[7]);
            *(u32x4*)(lds + G_VT + (2 * ep) * 144 + q8 * 16) = v0; *(u32x4*)(lds + G_VT + (2 * ep + 1) * 144 + q8 * 16) = v1;
#undef LO2
#undef HI2
        }
        LBAR();
        { const int nn = (n + 1 < 32) ? n + 1 : 31; GS_LOAD(nn, oz); }
        __builtin_amdgcn_sched_barrier(0);
        const int ln = OPQ(c.lane); const int m16 = ln & 15, g4 = ln >> 4;
        const int bA = (int)(uintptr_t)(lds + G_QA) + m16 * 528 + g4 * 8;
        const int bSC = (int)(uintptr_t)(lds + G_SC) + m16 * 144 + g4 * 16;
        const int bKT = (int)(uintptr_t)(lds + G_KBT) + m16 * 144 + g4 * 16;
        const int bF = (int)(uintptr_t)(lds + G_ER) + g4 * 16;
        const int bVT = (int)(uintptr_t)(lds + G_VT) + (16 * w + m16) * 144 + g4 * 16;
        f32x4 o[4];
#pragma unroll
        for (int ti = 0; ti < 4; ++ti) o[ti] = (f32x4){0.f, 0.f, 0.f, 0.f};
#define Q6(ks) do { \
        const u32x2 l0 = lds_rd64<0 * 8448 + (ks) * 64>(bA), h0 = lds_rd64<0 * 8448 + (ks) * 64 + 32>(bA), l1 = lds_rd64<1 * 8448 + (ks) * 64>(bA), h1 = lds_rd64<1 * 8448 + (ks) * 64 + 32>(bA); \
        const u32x2 l2 = lds_rd64<2 * 8448 + (ks) * 64>(bA), h2 = lds_rd64<2 * 8448 + (ks) * 64 + 32>(bA), l3 = lds_rd64<3 * 8448 + (ks) * 64>(bA), h3 = lds_rd64<3 * 8448 + (ks) * 64 + 32>(bA); \
        const u32x2 m0 = lds_rd64<0 * 8448 + (ks) * 64 + 64>(bA), n0 = lds_rd64<0 * 8448 + (ks) * 64 + 96>(bA), m1 = lds_rd64<1 * 8448 + (ks) * 64 + 64>(bA), n1 = lds_rd64<1 * 8448 + (ks) * 64 + 96>(bA); \
        const u32x2 m2 = lds_rd64<2 * 8448 + (ks) * 64 + 64>(bA), n2 = lds_rd64<2 * 8448 + (ks) * 64 + 96>(bA), m3 = lds_rd64<3 * 8448 + (ks) * 64 + 64>(bA), n3 = lds_rd64<3 * 8448 + (ks) * 64 + 96>(bA); \
        u32x4 bw0, bw1; bw0.x = cvt_pk_bf16(S[2 * (ks)][0], S[2 * (ks)][1]); bw0.y = cvt_pk_bf16(S[2 * (ks)][2], S[2 * (ks)][3]); \
        bw0.z = cvt_pk_bf16(S[2 * (ks) + 1][0], S[2 * (ks) + 1][1]); bw0.w = cvt_pk_bf16(S[2 * (ks) + 1][2], S[2 * (ks) + 1][3]); \
        bw1.x = cvt_pk_bf16(S[2 * (ks) + 2][0], S[2 * (ks) + 2][1]); bw1.y = cvt_pk_bf16(S[2 * (ks) + 2][2], S[2 * (ks) + 2][3]); \
        bw1.z = cvt_pk_bf16(S[2 * (ks) + 3][0], S[2 * (ks) + 3][1]); bw1.w = cvt_pk_bf16(S[2 * (ks) + 3][2], S[2 * (ks) + 3][3]); \
        LWAIT(); \
        o[0] = __builtin_amdgcn_mfma_f32_16x16x32_bf16(PKA(l0, h0), AS8(bw0), o[0], 0, 0, 0); o[1] = __builtin_amdgcn_mfma_f32_16x16x32_bf16(PKA(l1, h1), AS8(bw0), o[1], 0, 0, 0); \
        o[2] = __builtin_amdgcn_mfma_f32_16x16x32_bf16(PKA(l2, h2), AS8(bw0), o[2], 0, 0, 0); o[3] = __builtin_amdgcn_mfma_f32_16x16x32_bf16(PKA(l3, h3), AS8(bw0), o[3], 0, 0, 0); \
        o[0] = __builtin_amdgcn_mfma_f32_16x16x32_bf16(PKA(m0, n0), AS8(bw1), o[0], 0, 0, 0); o[1] = __builtin_amdgcn_mfma_f32_16x16x32_bf16(PKA(m1, n1), AS8(bw1), o[1], 0, 0, 0); \
        o[2] = __builtin_amdgcn_mfma_f32_16x16x32_bf16(PKA(m2, n2), AS8(bw1), o[2], 0, 0, 0); o[3] = __builtin_amdgcn_mfma_f32_16x16x32_bf16(PKA(m3, n3), AS8(bw1), o[3], 0, 0, 0); } while (0)
        Q6(0); Q6(2); Q6(4); Q6(6);
#undef Q6
        {
            const u32x4 vb0 = lds_rd128<0>(bVT), vb1 = lds_rd128<64>(bVT);
            const u32x4 s00 = lds_rd128<0 * 2304>(bSC), s01 = lds_rd128<0 * 2304 + 64>(bSC), s10 = lds_rd128<1 * 2304>(bSC), s11 = lds_rd128<1 * 2304 + 64>(bSC);
            const u32x4 s20 = lds_rd128<2 * 2304>(bSC), s21 = lds_rd128<2 * 2304 + 64>(bSC), s30 = lds_rd128<3 * 2304>(bSC), s31 = lds_rd128<3 * 2304 + 64>(bSC);
            LWAIT();
            o[0] = __builtin_amdgcn_mfma_f32_16x16x32_bf16(AS8(s00), AS8(vb0), o[0], 0, 0, 0); o[1] = __builtin_amdgcn_mfma_f32_16x16x32_bf16(AS8(s10), AS8(vb0), o[1], 0, 0, 0);
            o[2] = __builtin_amdgcn_mfma_f32_16x16x32_bf16(AS8(s20), AS8(vb0), o[2], 0, 0, 0); o[3] = __builtin_amdgcn_mfma_f32_16x16x32_bf16(AS8(s30), AS8(vb0), o[3], 0, 0, 0);
            o[0] = __builtin_amdgcn_mfma_f32_16x16x32_bf16(AS8(s01), AS8(vb1), o[0], 0, 0, 0); o[1] = __builtin_amdgcn_mfma_f32_16x16x32_bf16(AS8(s11), AS8(vb1), o[1], 0, 0, 0);
            o[2] = __builtin_amdgcn_mfma_f32_16x16x32_bf16(AS8(s21), AS8(vb1), o[2], 0, 0, 0); o[3] = __builtin_amdgcn_mfma_f32_16x16x32_bf16(AS8(s31), AS8(vb1), o[3], 0, 0, 0);
#define G8(t0) do { \
            const u32x4 k00 = lds_rd128<((t0) + 0) * 2304>(bKT), k01 = lds_rd128<((t0) + 0) * 2304 + 64>(bKT), k10 = lds_rd128<((t0) + 1) * 2304>(bKT), k11 = lds_rd128<((t0) + 1) * 2304 + 64>(bKT); \
            const u32x4 k20 = lds_rd128<((t0) + 2) * 2304>(bKT), k21 = lds_rd128<((t0) + 2) * 2304 + 64>(bKT), k30 = lds_rd128<((t0) + 3) * 2304>(bKT), k31 = lds_rd128<((t0) + 3) * 2304 + 64>(bKT); \
            const f32x4 c0 = lds_rdf<((t0) + 0) * 64>(bF), c1 = lds_rdf<((t0) + 1) * 64>(bF), c2 = lds_rdf<((t0) + 2) * 64>(bF), c3 = lds_rdf<((t0) + 3) * 64>(bF); \
            LWAIT(); \
            S[(t0) + 0] *= c0; S[(t0) + 1] *= c1; S[(t0) + 2] *= c2; S[(t0) + 3] *= c3; \
            S[(t0) + 0] = __builtin_amdgcn_mfma_f32_16x16x32_bf16(AS8(k00), AS8(vb0), S[(t0) + 0], 0, 0, 0); S[(t0) + 1] = __builtin_amdgcn_mfma_f32_16x16x32_bf16(AS8(k10), AS8(vb0), S[(t0) + 1], 0, 0, 0); \
            S[(t0) + 2] = __builtin_amdgcn_mfma_f32_16x16x32_bf16(AS8(k20), AS8(vb0), S[(t0) + 2], 0, 0, 0); S[(t0) + 3] = __builtin_amdgcn_mfma_f32_16x16x32_bf16(AS8(k30), AS8(vb0), S[(t0) + 3], 0, 0, 0); \
            S[(t0) + 0] = __builtin_amdgcn_mfma_f32_16x16x32_bf16(AS8(k01), AS8(vb1), S[(t0) + 0], 0, 0, 0); S[(t0) + 1] = __builtin_amdgcn_mfma_f32_16x16x32_bf16(AS8(k11), AS8(vb1), S[(t0) + 1], 0, 0, 0); \
            S[(t0) + 2] = __builtin_amdgcn_mfma_f32_16x16x32_bf16(AS8(k21), AS8(vb1), S[(t0) + 2], 0, 0, 0); S[(t0) + 3] = __builtin_amdgcn_mfma_f32_16x16x32_bf16(AS8(k31), AS8(vb1), S[(t0) + 3], 0, 0, 0); \
            } while (0)
            G8(0); G8(4);
#pragma unroll
            for (int ti = 0; ti < 4; ++ti) {
#pragma unroll
                for (int r = 0; r < 4; ++r) {
                    const int i = 16 * ti + 4 * g4 + r;
                    og[(size_t)GROW(n, i) * DM + h * 512 + dvs * 128 + 16 * w + m16] = f2bf(o[ti][r]);
                }
            }
            G8(8); G8(12);
#undef G8
        }
    }
    LBAR();
#undef GS_LOAD
}
#undef GROW
#undef OPQ

constexpr int M_WS = 0, M_SV = 34816, M_MU = 34816 + 65536, M_RS = M_MU + 512;
__device__ __forceinline__ void gmlp_item(const Ctx& c, int l, int b, int n, int g) {
    char* lds = c.lds;
    const bf16_t* P = (const bf16_t*)(c.a.ws + WS_P);
    const float* stats = (const float*)(c.a.ws + WS_ST);
    bf16_t* br0 = (bf16_t*)(c.a.ws + WS_BR);
    int gz = 0; asm volatile("" : "+v"(gz));
    const int tid = c.tid + gz, lane = tid & 63, w = c.wid;
    const int T0 = b * SEQ + n * 128;
    __syncthreads();
    if (tid < 128) {
        const float* sp = stats + (size_t)(T0 + tid) * 64; float s = 0.f, q = 0.f;
#pragma unroll
        for (int x = 0; x < 16; ++x) { const f32x4 t = *(const f32x4*)(sp + 4 * x); s += t[0] + t[2]; q += t[1] + t[3]; }
        const float mu = s * (1.f / 2048.f); const float var = fmaxf(q * (1.f / 2048.f) - mu * mu, 0.f);
        *(float*)(lds + M_MU + tid * 4) = mu; *(float*)(lds + M_RS + tid * 4) = rsqrtf(var + EPS);
    }
    {
        const float* wp = c.a.gws + ((size_t)(l * 8 + g) * 128) * 128;
#pragma unroll
        for (int it = 0; it < 8; ++it) { const int e = (it * NTHR + tid) * 4; const int p = e >> 7, q = e & 127;
            const f32x4 t = *(const f32x4*)(wp + e); u32x2 wv; wv.x = cvt_pk_bf16(t[0], t[1]); wv.y = cvt_pk_bf16(t[2], t[3]);
            *(u32x2*)(lds + M_WS + p * 272 + q * 2) = wv; }
    }
    __syncthreads();
    {
        const int c8 = (tid & 15) * 8;
#pragma unroll
        for (int it = 0; it < 8; ++it) {
            const int q = (tid >> 4) + 32 * (it & 3), ch = it >> 2; const int cabs = g * 256 + ch * 128 + c8;
            const u32x4 raw = __builtin_nontemporal_load((const u32x4*)(P + (size_t)(T0 + q) * LDP + C_AV + cabs));
            const float mu = *(const float*)(lds + M_MU + q * 4), rs = *(const float*)(lds + M_RS + q * 4);
            const f32x4 g0 = *(const f32x4*)(c.a.ln_g + l * 2048 + cabs), g1 = *(const f32x4*)(c.a.ln_g + l * 2048 + cabs + 4);
            const f32x4 b0 = *(const f32x4*)(c.a.ln_b + l * 2048 + cabs), b1 = *(const f32x4*)(c.a.ln_b + l * 2048 + cabs + 4);
            float v[8] = {bflo(raw.x), bfhi(raw.x), bflo(raw.y), bfhi(raw.y), bflo(raw.z), bfhi(raw.z), bflo(raw.w), bfhi(raw.w)};
#pragma unroll
            for (int j = 0; j < 4; ++j) { v[j] = (v[j] - mu) * rs * g0[j] + b0[j]; v[4 + j] = (v[4 + j] - mu) * rs * g1[j] + b1[j]; }
            u32x4 wv; wv.x = cvt_pk_bf16(v[0], v[1]); wv.y = cvt_pk_bf16(v[2], v[3]); wv.z = cvt_pk_bf16(v[4], v[5]); wv.w = cvt_pk_bf16(v[6], v[7]);
            *(u32x4*)(lds + M_SV + (ch * 2 + (q >> 6)) * 16384 + att::v_st(q & 63, c8)) = wv;
        }
    }
    __syncthreads();
    const int pb = w & 3, ch = w >> 2, r32 = lane & 31, hi = lane >> 5;
    f32x16 o[4] = {};
#pragma unroll
    for (int qt = 0; qt < 2; ++qt) {
        bf16x8 pa[4];
#pragma unroll
        for (int ks = 0; ks < 4; ++ks) pa[ks] = *(const bf16x8*)(lds + M_WS + (32 * pb + r32) * 272 + (64 * qt + 16 * ks + 8 * hi) * 2);
        const int vb = (int)(uintptr_t)(lds + M_SV + (ch * 2 + qt) * 16384) + att::v_rd_base(lane);
        att::pv_d0(o, vb, pa[0], pa[1], pa[2], pa[3]);
    }
    __syncthreads();
    {
        float* slab = (float*)(lds + w * 16896);
#pragma unroll
        for (int r = 0; r < 16; ++r)
#pragma unroll
            for (int d0 = 0; d0 < 4; ++d0) slab[att::crow(r, hi) * 132 + 32 * d0 + r32] = o[d0][r];
#pragma unroll
        for (int it = 0; it < 8; ++it) {
            const int row = it * 4 + (lane >> 4), c8 = (lane & 15) * 8;
            const int p = 32 * pb + row; const size_t tok = (size_t)(T0 + p); const int cabs = g * 256 + ch * 128 + c8;
            const f32x4 x0 = *(const f32x4*)(slab + row * 132 + c8), x1 = *(const f32x4*)(slab + row * 132 + c8 + 4);
            const u32x4 ur = __builtin_nontemporal_load((const u32x4*)(P + tok * LDP + C_AU + cabs)), zr = __builtin_nontemporal_load((const u32x4*)(P + tok * LDP + C_AZ + cabs));
            const float bsv = c.a.gbs[(size_t)(l * 8 + g) * 128 + p];
            float v[8];
            v[0] = (x0[0] + bsv) * bflo(ur.x) * bflo(zr.x); v[1] = (x0[1] + bsv) * bfhi(ur.x) * bfhi(zr.x);
            v[2] = (x0[2] + bsv) * bflo(ur.y) * bflo(zr.y); v[3] = (x0[3] + bsv) * bfhi(ur.y) * bfhi(zr.y);
            v[4] = (x1[0] + bsv) * bflo(ur.z) * bflo(zr.z); v[5] = (x1[1] + bsv) * bfhi(ur.z) * bfhi(zr.z);
            v[6] = (x1[2] + bsv) * bflo(ur.w) * bflo(zr.w); v[7] = (x1[3] + bsv) * bfhi(ur.w) * bfhi(zr.w);
            u32x4 wv; wv.x = cvt_pk_bf16(v[0], v[1]); wv.y = cvt_pk_bf16(v[2], v[3]); wv.z = cvt_pk_bf16(v[4], v[5]); wv.w = cvt_pk_bf16(v[6], v[7]);
            __builtin_nontemporal_store(wv, (u32x4*)(br0 + tok * DM + cabs));
        }
    }
}

__device__ __forceinline__ void combine_phase(const Ctx& c, int l) {
    const bf16_t* P = (const bf16_t*)(c.a.ws + WS_P);
    const bf16_t* og = (const bf16_t*)(c.a.ws + WS_OG); const bf16_t* oa = (const bf16_t*)(c.a.ws + WS_OA);
    bf16_t* br1 = (bf16_t*)(c.a.ws + WS_BR) + (size_t)MT * DM; bf16_t* br2 = br1 + (size_t)MT * DM;
    const int lane = c.lane;
    const float* lv = c.a.dlam + l * 512;
    float s01 = lv[lane] * lv[128 + lane] + lv[64 + lane] * lv[192 + lane];
    float s23 = lv[256 + lane] * lv[384 + lane] + lv[320 + lane] * lv[448 + lane];
    s01 = wave_sum(s01); s23 = wave_sum(s23);
    const float lam_init = 0.8f - 0.6f * expf(-0.3f * (float)l);
    const float lam = expf(s01) - expf(s23) + lam_init;
    const float oml = 1.f - lam_init;
    const f32x4 gn0 = *(const f32x4*)(c.a.gla_norm + l * 512 + lane * 8), gn1 = *(const f32x4*)(c.a.gla_norm + l * 512 + lane * 8 + 4);
    const f32x4 dn0 = *(const f32x4*)(c.a.dnorm + l * 256 + (lane & 31) * 8), dn1 = *(const f32x4*)(c.a.dnorm + l * 256 + (lane & 31) * 8 + 4);
    const int nw = c.G * 8;
    for (int task = c.bx * 8 + c.wid; task < MT * 8; task += nw) {
        const int tok = task >> 3, sub = task & 7; const int col = (sub & 3) * 512 + lane * 8;
        if (sub < 4) {
            const u32x4 a = __builtin_nontemporal_load((const u32x4*)(og + (size_t)tok * DM + col)), bq = __builtin_nontemporal_load((const u32x4*)(og + (size_t)(MT + tok) * DM + col));
            const u32x4 zr = __builtin_nontemporal_load((const u32x4*)(P + (size_t)tok * LDP + C_BZ + col));
            float v[8] = {bflo(a.x) + bflo(bq.x), bfhi(a.x) + bfhi(bq.x), bflo(a.y) + bflo(bq.y), bfhi(a.y) + bfhi(bq.y),
                          bflo(a.z) + bflo(bq.z), bfhi(a.z) + bfhi(bq.z), bflo(a.w) + bflo(bq.w), bfhi(a.w) + bfhi(bq.w)};
            float ss = 0.f;
#pragma unroll
            for (int j = 0; j < 8; ++j) ss += v[j] * v[j];
            ss = wave_sum(ss); const float ri = rsqrtf(ss * (1.f / 512.f) + EPS);
            const float z[8] = {bflo(zr.x), bfhi(zr.x), bflo(zr.y), bfhi(zr.y), bflo(zr.z), bfhi(zr.z), bflo(zr.w), bfhi(zr.w)};
#pragma unroll
            for (int j = 0; j < 4; ++j) { v[j] = v[j] * ri * gn0[j] * z[j]; v[4 + j] = v[4 + j] * ri * gn1[j] * z[4 + j]; }
            u32x4 wv; wv.x = cvt_pk_bf16(v[0], v[1]); wv.y = cvt_pk_bf16(v[2], v[3]); wv.z = cvt_pk_bf16(v[4], v[5]); wv.w = cvt_pk_bf16(v[6], v[7]);
            __builtin_nontemporal_store(wv, (u32x4*)(br1 + (size_t)tok * DM + col));
        } else {
            const u32x4 a = __builtin_nontemporal_load((const u32x4*)(oa + (size_t)tok * DM + col)), bq = __builtin_nontemporal_load((const u32x4*)(oa + (size_t)(MT + tok) * DM + col));
            const u32x4 zr = __builtin_nontemporal_load((const u32x4*)(P + (size_t)tok * LDP + C_CZ + col));
            float v[8] = {bflo(a.x) - lam * bflo(bq.x), bfhi(a.x) - lam * bfhi(bq.x), bflo(a.y) - lam * bflo(bq.y), bfhi(a.y) - lam * bfhi(bq.y),
                          bflo(a.z) - lam * bflo(bq.z), bfhi(a.z) - lam * bfhi(bq.z), bflo(a.w) - lam * bflo(bq.w), bfhi(a.w) - lam * bfhi(bq.w)};
            float ss = 0.f;
#pragma unroll
            for (int j = 0; j < 8; ++j) ss += v[j] * v[j];
#pragma unroll
            for (int o = 16; o >= 1; o >>= 1) ss += __shfl_xor(ss, o);
            const float ri = rsqrtf(ss * (1.f / 256.f) + EPS) * oml;
            const float z[8] = {bflo(zr.x), bfhi(zr.x), bflo(zr.y), bfhi(zr.y), bflo(zr.z), bfhi(zr.z), bflo(zr.w), bfhi(zr.w)};
#pragma unroll
            for (int j = 0; j < 4; ++j) { v[j] = v[j] * ri * dn0[j] * z[j]; v[4 + j] = v[4 + j] * ri * dn1[j] * z[4 + j]; }
            u32x4 wv; wv.x = cvt_pk_bf16(v[0], v[1]); wv.y = cvt_pk_bf16(v[2], v[3]); wv.z = cvt_pk_bf16(v[4], v[5]); wv.w = cvt_pk_bf16(v[6], v[7]);
            __builtin_nontemporal_store(wv, (u32x4*)(br2 + (size_t)tok * DM + col));
        }
    }
}


#define XB_TMO      128
#define XB_XCNT(j)  (256  + 64 * (j))
#define XB_XSUB(j)  (1280 + 64 * (j))
#define XB_XGEN(j)  (2304 + 64 * (j))
#define XB_TOP      3328
#define XB_TOPGEN   3392
#define XCD_BAR_WORDS 3456
#define XB_SPIN_CAP (1u << 18)
__device__ __forceinline__ unsigned xb_ld(unsigned* p)              { return __hip_atomic_load(p, __ATOMIC_RELAXED, __HIP_MEMORY_SCOPE_AGENT); }
__device__ __forceinline__ unsigned xb_add(unsigned* p, unsigned v) { return __hip_atomic_fetch_add(p, v, __ATOMIC_RELAXED, __HIP_MEMORY_SCOPE_AGENT); }
__device__ __forceinline__ unsigned xb_xcc_id() { return (unsigned)__builtin_amdgcn_s_getreg((3 << 11) | 20) & 0xFu; }
#define XB_SPIN(cond, bar) do { unsigned _sp = 0; while (cond) { __builtin_amdgcn_s_sleep(1); \
    if ((++_sp & 255u) == 0u) { if (xb_ld(&(bar)[XB_TMO])) break; if (_sp > XB_SPIN_CAP) { atomicAdd(&(bar)[XB_TMO], 1u); break; } } } } while (0)
struct XcdBarrier { unsigned* bar; unsigned x; volatile LAS unsigned* st; };
__device__ __forceinline__ void xcd_barrier_complete(unsigned* bar, unsigned x, unsigned& nloc, unsigned& nx) {
    const unsigned G = gridDim.x * gridDim.y * gridDim.z;
    unsigned sum, cnt, mine, sp = 0u;
    for (;;) {
        sum = 0u; cnt = 0u; mine = 0u;
#pragma unroll
        for (unsigned j = 0; j < 16; ++j) { const unsigned c = xb_ld(&bar[XB_XCNT(j)]); sum += c; cnt += (c > 0u) ? 1u : 0u; mine = (j == x) ? c : mine; }
        if (sum == G) break;
        __builtin_amdgcn_s_sleep(1);
        if ((++sp & 255u) == 0u) { if (xb_ld(&bar[XB_TMO])) break; if (sp > XB_SPIN_CAP) { atomicAdd(&bar[XB_TMO], 1u); break; } }
    }
    nloc = mine > 0u ? mine : 1u; nx = cnt > 0u ? cnt : 1u;
}
__device__ __forceinline__ void xcd_barrier(const XcdBarrier& b, const bool t0) {
    asm volatile("s_waitcnt vmcnt(0)" ::: "memory");
    __syncthreads();
    if (t0) {
        unsigned* bar = b.bar;
        __builtin_amdgcn_s_waitcnt(0);
        unsigned nloc = b.st[0], nx = b.st[1];
        if (nloc == 0u) { xcd_barrier_complete(bar, b.x, nloc, nx); b.st[0] = nloc; b.st[1] = nx; }
        const unsigned old = xb_add(&bar[XB_XSUB(b.x)], 1u);
        const unsigned gen = old / nloc;
        if (old + 1u == (gen + 1u) * nloc) {
            __builtin_amdgcn_fence(__ATOMIC_RELEASE, "agent");
            asm volatile("s_waitcnt vmcnt(0)" ::: "memory");
            const unsigned og = xb_add(&bar[XB_TOP], 1u);
            const unsigned tg = og / nx;
            if (og + 1u == (tg + 1u) * nx) xb_add(&bar[XB_TOPGEN], 1u);
            else XB_SPIN(xb_ld(&bar[XB_TOPGEN]) == tg, bar);
            __builtin_amdgcn_fence(__ATOMIC_ACQUIRE, "agent");
            xb_add(&bar[XB_XGEN(b.x)], 1u);
            asm volatile("s_waitcnt vmcnt(0)" ::: "memory");
        } else {
            XB_SPIN(xb_ld(&bar[XB_XGEN(b.x)]) == gen, bar);
            __builtin_amdgcn_fence(__ATOMIC_ACQUIRE, "agent");
            asm volatile("s_waitcnt vmcnt(0)" ::: "memory");
        }
    }
    __syncthreads();
}

__global__ void __launch_bounds__(NTHR, 2) mk_fwd(Args a) {
    extern __shared__ __attribute__((aligned(16))) unsigned char shm[];
    Ctx c; c.a = a; c.lds = (char*)shm;
    const int wid_s = __builtin_amdgcn_readfirstlane((int)threadIdx.x >> 6);
    LAS unsigned char* ldsl = (LAS unsigned char*)shm;
    XcdBarrier xb;
    { volatile LAS unsigned* st = (volatile LAS unsigned*)(ldsl + 147456);
      const bool t0 = (wid_s == 0) && (__builtin_amdgcn_mbcnt_hi(~0u, __builtin_amdgcn_mbcnt_lo(~0u, 0u)) == 0u);
      if (t0) { st[0] = 0u; st[1] = 0u; }
      __syncthreads();
      xb.bar = (unsigned*)(a.ws + WS_BAR); xb.x = xb_xcc_id(); xb.st = st;
      if (t0) st[2] = xb_add(&xb.bar[XB_XCNT(xb.x)], 1u); }
    int vcu_x = -1;
    for (int ph = a.ph_lo; ph < a.ph_hi; ++ph) {
        if (ph > a.ph_lo) {
            if (ph == a.ph_lo + 1) {
                if (a.ph_hi > 1000) cg::this_grid().sync();
                xcd_barrier(xb, (wid_s == 0) && (__builtin_amdgcn_mbcnt_hi(~0u, __builtin_amdgcn_mbcnt_lo(~0u, 0u)) == 0u));
                volatile LAS unsigned* st = (volatile LAS unsigned*)(ldsl + 147456);
                if ((wid_s == 0) && (__builtin_amdgcn_mbcnt_hi(~0u, __builtin_amdgcn_mbcnt_lo(~0u, 0u)) == 0u)) {
                    unsigned pre = 0u, tot = 0u;
#pragma unroll
                    for (unsigned jx = 0; jx < 16; ++jx) { const unsigned cn = xb_ld(&xb.bar[XB_XCNT(jx)]); pre += (jx < xb.x) ? cn : 0u; tot += cn; }
                    st[3] = (tot == gridDim.x) ? pre + st[2] : blockIdx.x;
                }
                __syncthreads();
                vcu_x = __builtin_amdgcn_readfirstlane((int)st[3]);
            }
            else xcd_barrier(xb, (wid_s == 0) && (__builtin_amdgcn_mbcnt_hi(~0u, __builtin_amdgcn_mbcnt_lo(~0u, 0u)) == 0u));
        }
        { int vz = 0, sz = 0; asm volatile("" : "+v"(vz)); asm volatile("" : "+s"(sz));
          c.tid = wid_s * 64 + (int)__builtin_amdgcn_mbcnt_hi(~0u, __builtin_amdgcn_mbcnt_lo(~0u, 0u)) + vz; c.lane = c.tid & 63; c.wid = __builtin_amdgcn_readfirstlane(c.tid >> 6);
          { typedef __attribute__((address_space(1))) unsigned char gu8; gu8* wsp = (gu8*)a.ws; asm volatile("" : "+s"(wsp)); c.a.ws = (unsigned char*)wsp; }
          c.G = gridDim.x; c.bx = (int)blockIdx.x + sz; c.vcu = (vcu_x >= 0) ? vcu_x + sz : ((c.G % 8 == 0) ? (c.bx % 8) * (c.G / 8) + c.bx / 8 : c.bx); }
        unsigned char* const ws = c.a.ws;
        const int l = ph / 7, sp = ph % 7;
        if (ph == 14) { row_pass(c, 2, nullptr, a.norm_post + DM); continue; }
        if (sp == 0) {
            if (l == 0) { if (c.bx == 0) bias_table(c); row_pass(c, 0, a.norm_pre, nullptr); }
            else row_pass(c, 1, a.norm_pre + DM, a.norm_post);
            wconv_job(c, a.w_in + (size_t)l * 2048 * 20512, 20512, (bf16_t*)(ws + WS_W), N1, 1, 1);
        } else if (sp == 1) {
            pg8::Gemm g{(const bf16_t*)(ws + WS_H), (const bf16_t*)(ws + WS_W), MT, NP, DM};
            pg8::StaticOrder S; S.init(MT, NP, c.G, c.bx);
            pg8::Epi1 E{(bf16_t*)(ws + WS_P), (float*)(ws + WS_LR), (float*)(ws + WS_ST)};
#ifndef NO_G1
            pg8::gemm_phase<pg8::Epi1>(ldsl, g, S, E, c.tid);
#endif
        } else if (sp == 2) {
            for (int q = 0; ; ++q) {
                const int item = c.vcu + (q >> 3) * c.G; if (item >= 256) break;
                const int b = item >> 5, nb = item & 31, hd = q & 7;
                if (hd == 0) gla_lr_block(c, b, nb);
                gla_pre_item(c, l, b, hd >> 1, hd & 1, (hd & 1) ? 31 - nb : nb);
            }
        } else if (sp == 3) {
#ifndef NO_GLA
            for (int it = c.vcu; it < 256; it += c.G) gla_scan_item(c, l, it >> 5, (it >> 3) & 3, (it >> 2) & 1, it & 3);
#endif
#ifndef NO_ATT
            for (int it = c.vcu; it < 2048; it += c.G) attn2_item(c, it >> 8, (it >> 5) & 7, (it >> 4) & 1, it & 15);
#endif
#ifndef NO_GMLP
            for (int it = c.vcu; it < 1024; it += c.G) gmlp_item(c, l, it >> 7, (it >> 3) & 15, it & 7);
#endif
            __syncthreads();
            wconv_job(c, a.w_merge + (size_t)l * 2048 * 6144, 6144, (bf16_t*)(ws + WS_WM), 6144, 0, 1);
            wconv_job(c, a.w_branch + (size_t)(l * 3) * 2048 * 2048, 2048, (bf16_t*)(ws + WS_WB), 2048, 0, 3);
            wconv_job(c, a.w_out + (size_t)l * 2048 * 2048, 2048, (bf16_t*)(ws + WS_WO), 2048, 0, 1);
        } else if (sp == 4) {
            combine_phase(c, l);
        } else if (sp == 5) {
            pg8::StaticOrder S; S.init(MT, DM, c.G, c.bx);
            for (int i = 0; i < 3; ++i) {
                { pg8::Gemm g{(const bf16_t*)(ws + WS_H), (const bf16_t*)(ws + WS_WM) + (size_t)i * 2048 * 2048, MT, DM, DM};
                  pg8::EpiGate E{(bf16_t*)(ws + WS_GATE) + (size_t)i * MT * DM, a.b_merge + l * 6144 + i * 2048};
#ifndef NO_G4A
                  pg8::gemm_phase<pg8::EpiGate>(ldsl, g, S, E, c.tid);
#endif
 }
                { pg8::Gemm g{(const bf16_t*)(ws + WS_BR) + (size_t)i * MT * DM, (const bf16_t*)(ws + WS_WB) + (size_t)i * 2048 * 2048, MT, DM, DM};
                  pg8::EpiBranch E{(const bf16_t*)(ws + WS_GATE) + (size_t)i * MT * DM, (const bf16_t*)(ws + WS_MF) + (size_t)(i > 0 ? i - 1 : 0) * MT * DM, (i < 2) ? (bf16_t*)(ws + WS_MF) + (size_t)i * MT * DM : (bf16_t*)(ws + WS_MB), i};
#ifndef NO_G4B
                  pg8::gemm_phase<pg8::EpiBranch>(ldsl, g, S, E, c.tid);
#endif
 }
            }
        } else {
            pg8::Gemm g{(const bf16_t*)(ws + WS_MB), (const bf16_t*)(ws + WS_WO), MT, DM, DM};
            pg8::StaticOrder S; S.init(MT, DM, c.G, c.bx);
            pg8::EpiBf16Out E{(bf16_t*)(ws + WS_OUTF), DM};
#ifndef NO_G5
            pg8::gemm_phase<pg8::EpiBf16Out>(ldsl, g, S, E, c.tid);
#endif
        }
    }
}


#ifdef TESTK
__global__ void __launch_bounds__(NTHR, 2) tk(const bf16_t* A, const bf16_t* Bt, float* C) {
    extern __shared__ __attribute__((aligned(16))) unsigned char shm[];
    pg8::Gemm g{A, Bt, MT, DM, DM};
    pg8::StaticOrder S; S.init(MT, DM, gridDim.x, blockIdx.x);
    pg8::EpiF32 E{C, DM};
    pg8::gemm_phase<pg8::EpiF32>((LAS unsigned char*)shm, g, S, E, threadIdx.x);
}
#endif
extern "C" void kernel_launch(void* const* d_in, const int* in_sizes, int n_in, void* d_out, int out_size, void* d_ws, size_t ws_size, hipStream_t stream) {
    static int grid = 0;
    if (grid == 0) {
        if (n_in != 18 || out_size != MT * DM || ws_size < WS_END) { fprintf(stderr, "kernel_launch: unexpected shapes (n_in %d out %d ws %zu need %zu)\n", n_in, out_size, ws_size, (size_t)WS_END); grid = -1; return; }
        if (hipFuncSetAttribute((const void*)mk_fwd, hipFuncAttributeMaxDynamicSharedMemorySize, LDS_BYTES) != hipSuccess) { fprintf(stderr, "kernel_launch: hipFuncSetAttribute failed\n"); grid = -1; return; }
        int dev = 0, cus = 0, per_cu = 0;
        hipGetDevice(&dev); hipDeviceGetAttribute(&cus, hipDeviceAttributeMultiprocessorCount, dev);
        hipOccupancyMaxActiveBlocksPerMultiprocessor(&per_cu, (const void*)mk_fwd, NTHR, LDS_BYTES);
        (void)hipGetLastError();
        if (per_cu < 1) per_cu = 1;
        grid = cus;
    }
    if (grid < 0) return;
    (void)hipMemsetAsync((char*)d_ws + WS_BAR, 0, 16384, stream);
    Args a{};
    a.x = (const float*)d_in[0]; a.norm_pre = (const float*)d_in[1]; a.w_in = (const float*)d_in[2]; a.ln_g = (const float*)d_in[3]; a.ln_b = (const float*)d_in[4];
    a.gws = (const float*)d_in[5]; a.gbs = (const float*)d_in[6]; a.wa2 = (const float*)d_in[7]; a.ba = (const float*)d_in[8]; a.gla_norm = (const float*)d_in[9];
    a.dlam = (const float*)d_in[10]; a.dnorm = (const float*)d_in[11]; a.rel_bias = (const float*)d_in[12]; a.w_branch = (const float*)d_in[13]; a.w_merge = (const float*)d_in[14];
    a.b_merge = (const float*)d_in[15]; a.w_out = (const float*)d_in[16]; a.norm_post = (const float*)d_in[17];
    a.out = (float*)d_out; a.ws = (unsigned char*)d_ws;
#if MK_ONE_LAUNCH
    a.ph_lo = 0; a.ph_hi = 15;
    void* args[] = {&a};
    hipError_t e = hipLaunchCooperativeKernel((const void*)mk_fwd, dim3(grid), dim3(NTHR), args, LDS_BYTES, stream);
    if (e != hipSuccess) fprintf(stderr, "cooperative launch failed: %s (grid %d)\n", hipGetErrorString(e), grid);
#else
    for (int ph = 0; ph < 15; ++ph) {
        a.ph_lo = ph; a.ph_hi = ph + 1;
        hipLaunchKernelGGL(mk_fwd, dim3(grid), dim3(NTHR), LDS_BYTES, stream, a);
    }
#endif
}
```

```cpp
#include <hip/hip_runtime.h>
#include <hip/hip_cooperative_groups.h>
#include <cstdio>
#include <cstdint>
namespace cg = cooperative_groups;

#ifndef MK_ONE_LAUNCH
#define MK_ONE_LAUNCH 1
#endif

#define LAS __attribute__((address_space(3)))
typedef unsigned short bf16_t;
typedef short bf16x8 __attribute__((ext_vector_type(8)));
typedef short s16x4 __attribute__((ext_vector_type(4)));
typedef float f32x4 __attribute__((ext_vector_type(4)));
typedef float f32x2 __attribute__((ext_vector_type(2)));
typedef float f32x16 __attribute__((ext_vector_type(16)));
typedef unsigned u32x4 __attribute__((ext_vector_type(4)));
typedef unsigned u32x2 __attribute__((ext_vector_type(2)));

constexpr int MT = 16384, DM = 2048, SEQ = 2048;
constexpr int NP = 20480, LDP = 20480 + 64, N1 = 20736;
constexpr int C_AU = 0, C_AV = 2048, C_AZ = 4096, C_BQ = 6144, C_BK = 7168, C_BV = 8192, C_BZ = 10240, C_CQ = 12288, C_CK = 14336, C_CV = 16384, C_CZ = 18432;
constexpr float EPS = 1e-6f;
constexpr int NTHR = 512;
constexpr int LDS_BYTES = 147456 + 256;

constexpr size_t WS_W = 0;
constexpr size_t WS_WM = 0, WS_WB = 25165824, WS_WO = 50331648;
constexpr size_t WS_H = 84934656;
constexpr size_t WS_P = WS_H + 67108864;
constexpr size_t WS_GATE = WS_P, WS_MF = WS_P + 201326592, WS_MB = WS_P + 469762048, WS_OUTF = WS_P + 536870912;
constexpr size_t WS_LR = WS_P + (size_t)MT * LDP * 2;
constexpr size_t WS_ST = WS_LR + 2097152;
constexpr size_t WS_OG = WS_ST + 4194304;
constexpr size_t WS_OA = WS_OG + 134217728;
constexpr size_t WS_BR = WS_OA + 134217728;
constexpr size_t WS_TB = WS_BR + 201326592;
constexpr size_t WS_GQA = WS_BR + 67108864, WS_GKT = WS_BR + 134217728;
constexpr size_t WS_GSC = WS_TB + 16384, WS_GEC = WS_GSC + 16777216;
constexpr size_t WS_BAR = WS_GEC + 4194304;
constexpr size_t WS_END = WS_BAR + 16384;

struct Args {
    const float* x; const float* norm_pre; const float* w_in; const float* ln_g; const float* ln_b; const float* gws; const float* gbs;
    const float* wa2; const float* ba; const float* gla_norm; const float* dlam; const float* dnorm; const float* rel_bias;
    const float* w_branch; const float* w_merge; const float* b_merge; const float* w_out; const float* norm_post;
    float* out; unsigned char* ws; int ph_lo, ph_hi;
};

typedef __bf16 bf16x2_t __attribute__((ext_vector_type(2)));
__device__ __forceinline__ unsigned cvt_pk_bf16(float lo, float hi) { f32x2 v = {lo, hi}; bf16x2_t b = __builtin_convertvector(v, bf16x2_t); return __builtin_bit_cast(unsigned, b); }
__device__ __forceinline__ bf16_t f2bf(float f) { return (bf16_t)(cvt_pk_bf16(f, 0.f) & 0xffffu); }
__device__ __forceinline__ float bflo(unsigned u) { return __uint_as_float(u << 16); }
__device__ __forceinline__ float bfhi(unsigned u) { return __uint_as_float(u & 0xffff0000u); }
__device__ __forceinline__ float bf2f(bf16_t b) { return __uint_as_float(((unsigned)b) << 16); }
__device__ __forceinline__ float sigmoidf_(float x) { return __builtin_amdgcn_rcpf(1.f + __expf(-x)); }
__device__ __forceinline__ float siluf_(float x) { return x * sigmoidf_(x); }
__device__ __forceinline__ float gelu_tanh(float x) { const float y2 = 1.5957691216057308f * (x + 0.044715f * x * x * x); return x * sigmoidf_(y2); }
__device__ __forceinline__ float logsig(float z) { return fminf(z, 0.f) - __logf(1.f + __expf(-fabsf(z))); }
__device__ __forceinline__ float wave_sum(float v) {
#pragma unroll
    for (int o = 32; o >= 1; o >>= 1) v += __shfl_xor(v, o);
    return v;
}

namespace pg8 {
constexpr int BM = 256, BK = 64, HALF = 128, HTB = HALF * BK * 2, STAGE_BYTES = 8 * HTB, NXCD = 8, WGM = 8;
__host__ __device__ __forceinline__ int lds_byte(int r, int c) { const int st = (r >> 4) * 2 + (c >> 5), rr = r & 15, cc = c & 31, ob = rr * 64 + cc * 2; return st * 1024 + (ob ^ (((ob >> 9) & 1) << 5)); }
__host__ __device__ __forceinline__ void stage_rc(int b, int& R, int& C) { const int st = b / 1024, sb = b % 1024, swz = sb ^ (((sb >> 9) & 1) << 5); R = (st >> 1) * 16 + swz / 64; C = (st & 1) * 32 + (swz % 64) / 2; }
__host__ __device__ __forceinline__ int perm32(int rho) { const int n = rho >> 4, i = rho & 15; return 8 * (i >> 2) + 4 * n + (i & 3); }
struct Unit { int pm, pn; };
struct Gemm { const bf16_t* A; const bf16_t* Bt; int M, N, K; };
struct StaticOrder {
    int nM, nN, nwg, G, c;
    __device__ void init(int M, int N, int G_, int c_) { nM = M / BM; nN = N / BM; nwg = nM * nN; G = G_; c = c_; }
    __device__ bool next(int i, Unit& u) const {
        const long L = (long)i * G + c; if (L >= nwg) return false;
        int wgid = (int)L; { const int q = nwg / NXCD, r = nwg % NXCD, xcd = wgid % NXCD, off = wgid / NXCD; wgid = (xcd < r ? xcd * (q + 1) : r * (q + 1) + (xcd - r) * q) + off; }
        const int nig = WGM * nN, gid = wgid / nig, fm = gid * WGM, gsz = (nM - fm) < WGM ? (nM - fm) : WGM;
        u.pm = fm + ((wgid % nig) % gsz); u.pn = (wgid % nig) / gsz; return true;
    }
};

template <class Epi, bool ALIGN_EPI = true, bool SP2 = true>
__device__ __forceinline__ void gemm_phase(LAS unsigned char* lds, const Gemm g, const StaticOrder& S, const Epi& E, const int tid) {
    const int wid = __builtin_amdgcn_readfirstlane(tid >> 6), lane = tid & 63, wr = wid >> 2, wc = wid & 3, fr = lane & 15, fq = lane >> 4;
    const int K = g.K, nt = K / BK;
    unsigned voffA[2], voffB[2];
#pragma unroll
    for (int i = 0; i < 2; ++i) { int R, C; stage_rc(tid * 16 + i * 8192, R, C); const int Rb = Epi::PERM ? ((R & ~31) + perm32(R & 31)) : R;
        voffA[i] = (unsigned)(R * K + C) * 2u; voffB[i] = (unsigned)(Rb * K + C) * 2u; }
    const size_t kstep = (size_t)(BK * 2);
    const size_t hstep = (size_t)HALF * K * 2;
    const size_t tstep = 2 * hstep;
    const unsigned ldsw = (unsigned)wid * 1024u;
    const int aoff = lds_byte(wr * 64 + fr, fq * 8), boff = lds_byte(wc * 32 + fr, fq * 8);
#define PG8_SA(b, h) (((b) * 2 + (h)) * HTB)
#define PG8_SB(b, h) ((4 + (b) * 2 + (h)) * HTB)
#define PG8_STAGE(bufoff, gbase, voff) do { _Pragma("unroll") for (int _i = 0; _i < 2; ++_i) \
        __builtin_amdgcn_global_load_lds((const unsigned*)((const char*)(gbase) + (voff)[_i]), (LAS unsigned*)(lds + (bufoff) + ldsw + _i * 8192), 16, 0, 0); } while (0)
#define PG8_LDA(dst, b, h) do { _Pragma("unroll") for (int m = 0; m < 4; ++m) _Pragma("unroll") for (int k = 0; k < 2; ++k) dst[m][k] = *(const LAS bf16x8*)(lds + PG8_SA(b, h) + aoff + m * 2048 + k * 1024); } while (0)
#define PG8_LDB(dst, b, h) do { _Pragma("unroll") for (int n = 0; n < 2; ++n) _Pragma("unroll") for (int k = 0; k < 2; ++k) dst[n][k] = *(const LAS bf16x8*)(lds + PG8_SB(b, h) + boff + n * 2048 + k * 1024); } while (0)
#define PG8_MMA(ai, bj, At, Bt) do { __builtin_amdgcn_s_setprio(1); _Pragma("unroll") for (int m = 0; m < 4; ++m) _Pragma("unroll") for (int n = 0; n < 2; ++n) _Pragma("unroll") for (int k = 0; k < 2; ++k) \
        acc[ai][bj][m][n] = __builtin_amdgcn_mfma_f32_16x16x32_bf16(Bt[n][k], At[m][k], acc[ai][bj][m][n], 0, 0, 0); __builtin_amdgcn_s_setprio(0); } while (0)
#define PG8_WAIT_V(n) asm volatile("s_waitcnt vmcnt(" #n ")" ::: "memory")
#define PG8_WAIT_L(n) asm volatile("s_waitcnt lgkmcnt(" #n ")" ::: "memory")
#define PG8_BAR __builtin_amdgcn_s_barrier()
#define PG8_SCHED __builtin_amdgcn_sched_barrier(0)
    Unit cur, nxt; int ui = 0;
    if (!S.next(0, cur)) return;
    f32x4 acc[2][2][4][2];
#pragma unroll
    for (int a = 0; a < 2; ++a)
#pragma unroll
        for (int b = 0; b < 2; ++b)
#pragma unroll
            for (int m = 0; m < 4; ++m)
#pragma unroll
                for (int n = 0; n < 2; ++n) acc[a][b][m][n] = (f32x4){0.f, 0.f, 0.f, 0.f};
    bf16x8 At[4][2], B0[2][2], B1[2][2];
    const char* cA = (const char*)g.A + (size_t)cur.pm * tstep; const char* cB = (const char*)g.Bt + (size_t)cur.pn * tstep;
    if constexpr (SP2) {
        PG8_STAGE(PG8_SB(0, 0), cB, voffB); PG8_STAGE(PG8_SB(0, 1), cB + hstep, voffB); PG8_STAGE(PG8_SA(0, 0), cA, voffA); PG8_STAGE(PG8_SA(0, 1), cA + hstep, voffA);
        if (wr == 1) PG8_BAR;
        PG8_WAIT_V(2); PG8_BAR;
        PG8_STAGE(PG8_SB(1, 0), cB + kstep, voffB); PG8_STAGE(PG8_SA(1, 0), cA + kstep, voffA); PG8_STAGE(PG8_SB(1, 1), cB + hstep + kstep, voffB);
        PG8_WAIT_V(6); PG8_BAR;
    } else {
        PG8_STAGE(PG8_SB(0, 0), cB, voffB); PG8_STAGE(PG8_SA(0, 0), cA, voffA); PG8_STAGE(PG8_SB(0, 1), cB + hstep, voffB); PG8_STAGE(PG8_SA(0, 1), cA + hstep, voffA);
        if (wr == 1) PG8_BAR;
        PG8_WAIT_V(4); PG8_BAR;
        PG8_STAGE(PG8_SB(1, 0), cB + kstep, voffB); PG8_STAGE(PG8_SA(1, 0), cA + kstep, voffA); PG8_STAGE(PG8_SB(1, 1), cB + hstep + kstep, voffB);
        PG8_WAIT_V(6); PG8_BAR;
    }
    for (;;) {
        const bool has_next = S.next(ui + 1, nxt);
        const char* nA = has_next ? (const char*)g.A + (size_t)nxt.pm * tstep : cA; const char* nB = has_next ? (const char*)g.Bt + (size_t)nxt.pn * tstep : cB;
        for (int t = 0; t < nt; t += 2) {
            const bool last = (t == nt - 2);
            const char* a1 = cA + (size_t)(t + 1) * kstep;
            const char* a2 = last ? nA : cA + (size_t)(t + 2) * kstep; const char* b2 = last ? nB : cB + (size_t)(t + 2) * kstep;
            const char* a3 = a2 + kstep; const char* b3 = b2 + kstep;
            if constexpr (SP2) {
            PG8_LDB(B0, 0, 0); PG8_LDB(B1, 0, 1); PG8_SCHED; PG8_LDA(At, 0, 0); PG8_STAGE(PG8_SA(1, 1), a1 + hstep, voffA);
            PG8_WAIT_V(8); PG8_WAIT_L(0); PG8_BAR; PG8_MMA(0, 0, At, B0); PG8_MMA(0, 1, At, B1); PG8_BAR; PG8_SCHED;
            PG8_LDA(At, 0, 1); PG8_STAGE(PG8_SB(0, 0), b2, voffB); PG8_STAGE(PG8_SB(0, 1), b2 + hstep, voffB); PG8_STAGE(PG8_SA(0, 0), a2, voffA);
            PG8_WAIT_V(8); PG8_WAIT_L(0); PG8_BAR; PG8_MMA(1, 0, At, B0); PG8_MMA(1, 1, At, B1); PG8_BAR; PG8_SCHED;
            PG8_LDB(B0, 1, 0); PG8_LDB(B1, 1, 1); PG8_SCHED; PG8_LDA(At, 1, 0); PG8_STAGE(PG8_SA(0, 1), a2 + hstep, voffA);
            PG8_WAIT_V(8); PG8_WAIT_L(0); PG8_BAR; PG8_MMA(0, 0, At, B0); PG8_MMA(0, 1, At, B1); PG8_BAR; PG8_SCHED;
            PG8_LDA(At, 1, 1); PG8_STAGE(PG8_SB(1, 0), b3, voffB); PG8_STAGE(PG8_SB(1, 1), b3 + hstep, voffB); PG8_STAGE(PG8_SA(1, 0), a3, voffA);
            PG8_WAIT_V(8); PG8_WAIT_L(0); PG8_BAR; PG8_MMA(1, 0, At, B0); PG8_MMA(1, 1, At, B1); PG8_BAR; PG8_SCHED;
            } else {
            PG8_LDB(B0, 0, 0); PG8_SCHED; PG8_LDA(At, 0, 0); PG8_STAGE(PG8_SA(1, 1), a1 + hstep, voffA);
            PG8_WAIT_L(8); PG8_BAR; PG8_WAIT_L(0); PG8_MMA(0, 0, At, B0); PG8_BAR; PG8_SCHED;
            PG8_LDB(B1, 0, 1); PG8_STAGE(PG8_SB(0, 0), b2, voffB);
            PG8_BAR; PG8_WAIT_L(0); PG8_MMA(0, 1, At, B1); PG8_BAR;
            PG8_LDA(At, 0, 1); PG8_STAGE(PG8_SA(0, 0), a2, voffA);
            PG8_BAR; PG8_WAIT_L(0); PG8_MMA(1, 0, At, B0); PG8_BAR; PG8_SCHED;
            PG8_STAGE(PG8_SB(0, 1), b2 + hstep, voffB);
            PG8_WAIT_V(6); PG8_BAR; PG8_MMA(1, 1, At, B1); PG8_BAR;
            PG8_LDB(B0, 1, 0); PG8_SCHED; PG8_LDA(At, 1, 0); PG8_STAGE(PG8_SA(0, 1), a2 + hstep, voffA);
            PG8_WAIT_L(8); PG8_BAR; PG8_WAIT_L(0); PG8_MMA(0, 0, At, B0); PG8_BAR; PG8_SCHED;
            PG8_LDB(B1, 1, 1); PG8_STAGE(PG8_SB(1, 0), b3, voffB);
            PG8_BAR; PG8_WAIT_L(0); PG8_MMA(0, 1, At, B1); PG8_BAR;
            PG8_LDA(At, 1, 1); PG8_STAGE(PG8_SA(1, 0), a3, voffA);
            PG8_BAR; PG8_WAIT_L(0); PG8_MMA(1, 0, At, B0); PG8_BAR; PG8_SCHED;
            PG8_STAGE(PG8_SB(1, 1), b3 + hstep, voffB);
            PG8_WAIT_V(6); PG8_BAR; PG8_MMA(1, 1, At, B1); PG8_BAR;
            }
        }
        if constexpr (ALIGN_EPI) { if (wr == 0) PG8_BAR; }
        E(acc, cur, wr, wc, fr, fq);
        if (!has_next) break;
#pragma unroll
        for (int a = 0; a < 2; ++a)
#pragma unroll
            for (int b = 0; b < 2; ++b)
#pragma unroll
                for (int m = 0; m < 4; ++m)
#pragma unroll
                    for (int n = 0; n < 2; ++n) acc[a][b][m][n] = (f32x4){0.f, 0.f, 0.f, 0.f};
        cur = nxt; cA = nA; cB = nB; ++ui;
        if constexpr (ALIGN_EPI) { if (wr == 1) PG8_BAR; }
    }
    PG8_WAIT_V(0);
    if constexpr (!ALIGN_EPI) { if (wr == 0) PG8_BAR; }
    PG8_BAR;
#undef PG8_SA
#undef PG8_SB
#undef PG8_STAGE
#undef PG8_LDA
#undef PG8_LDB
#undef PG8_MMA
#undef PG8_WAIT_V
#undef PG8_WAIT_L
#undef PG8_BAR
#undef PG8_SCHED
}

struct EpiF32 {
    static constexpr bool PERM = false;
    float* C; int ldc;
    __device__ __forceinline__ void operator()(const f32x4 (&acc)[2][2][4][2], const Unit& u, int wr, int wc, int fr, int fq) const {
        const int row0 = u.pm * BM + wr * 64 + fr, col0 = u.pn * BM + wc * 32 + 4 * fq;
#pragma unroll
        for (int ai = 0; ai < 2; ++ai)
#pragma unroll
            for (int m = 0; m < 4; ++m) { float* rowp = C + (size_t)(row0 + ai * HALF + m * 16) * ldc + col0;
#pragma unroll
                for (int bj = 0; bj < 2; ++bj)
#pragma unroll
                    for (int n = 0; n < 2; ++n) *(f32x4*)(rowp + bj * HALF + n * 16) = acc[ai][bj][m][n]; }
    }
};
struct EpiBf16Out {
    static constexpr bool PERM = true;
    bf16_t* O; int ldc;
    __device__ __forceinline__ void operator()(const f32x4 (&acc)[2][2][4][2], const Unit& u, int wr, int wc, int fr, int fq) const {
        const int row0 = u.pm * BM + wr * 64 + fr; const int col0 = u.pn * BM + wc * 32 + 8 * fq;
#pragma unroll
        for (int ai = 0; ai < 2; ++ai)
#pragma unroll
            for (int m = 0; m < 4; ++m) { bf16_t* rowp = O + (size_t)(row0 + ai * HALF + m * 16) * ldc + col0;
#pragma unroll
                for (int bj = 0; bj < 2; ++bj) { const f32x4 v0 = acc[ai][bj][m][0], v1 = acc[ai][bj][m][1];
                    u32x4 w; w.x = cvt_pk_bf16(v0[0], v0[1]); w.y = cvt_pk_bf16(v0[2], v0[3]); w.z = cvt_pk_bf16(v1[0], v1[1]); w.w = cvt_pk_bf16(v1[2], v1[3]);
                    __builtin_nontemporal_store(w, (u32x4*)(rowp + bj * HALF)); } }
    }
};
struct Epi1 {
    static constexpr bool PERM = true;
    bf16_t* P; float* lr; float* stats;
    template <int KIND> __device__ __forceinline__ void run(const f32x4 (&acc)[2][2][4][2], const Unit& u, int wr, int wc, int fr, int fq, bool dost) const {
        const int row0 = u.pm * BM + wr * 64 + fr; const int col0 = u.pn * BM + wc * 32 + 8 * fq;
#pragma unroll
        for (int ai = 0; ai < 2; ++ai)
#pragma unroll
            for (int m = 0; m < 4; ++m) {
                const int row = row0 + ai * HALF + m * 16;
                bf16_t* rowp = P + (size_t)row * LDP + col0;
                float s = 0.f, q = 0.f;
#pragma unroll
                for (int bj = 0; bj < 2; ++bj) {
                    float v[8];
#pragma unroll
                    for (int j = 0; j < 4; ++j) { v[j] = acc[ai][bj][m][0][j]; v[4 + j] = acc[ai][bj][m][1][j]; }
#pragma unroll
                    for (int j = 0; j < 8; ++j) {
                        if (KIND == 1) v[j] = gelu_tanh(v[j]);
                        if (KIND == 2) v[j] = siluf_(v[j]);
                        if (KIND == 3) v[j] = v[j] * 0.0625f;
                    }
                    if (KIND == 1) {
#pragma unroll
                        for (int j = 0; j < 8; ++j) { s += v[j]; q += v[j] * v[j]; }
                    }
                    u32x4 w; w.x = cvt_pk_bf16(v[0], v[1]); w.y = cvt_pk_bf16(v[2], v[3]); w.z = cvt_pk_bf16(v[4], v[5]); w.w = cvt_pk_bf16(v[6], v[7]);
                    __builtin_nontemporal_store(w, (u32x4*)(rowp + bj * HALF));
                }
                if (KIND == 1) {
                    if (dost) {
                        s += __shfl_xor(s, 16); s += __shfl_xor(s, 32); q += __shfl_xor(q, 16); q += __shfl_xor(q, 32);
                        if (fq == 0) { *(f32x2*)(stats + ((size_t)row * 32 + (u.pn - 8) * 4 + wc) * 2) = (f32x2){s, q}; }
                    }
                }
            }
    }
    __device__ __forceinline__ void operator()(const f32x4 (&acc)[2][2][4][2], const Unit& u, int wr, int wc, int fr, int fq) const {
        const int pn = u.pn;
        if (pn == 80) {
            if (wc == 0) {
                const int row0 = u.pm * BM + wr * 64 + fr;
#pragma unroll
                for (int ai = 0; ai < 2; ++ai)
#pragma unroll
                    for (int m = 0; m < 4; ++m) { float* rp = lr + (size_t)(row0 + ai * HALF + m * 16) * 32 + 8 * fq;
                        *(f32x4*)(rp) = acc[ai][0][m][0]; *(f32x4*)(rp + 4) = acc[ai][0][m][1]; }
            }
            return;
        }
        if (pn < 16) run<1>(acc, u, wr, wc, fr, fq, pn >= 8);
        else if ((pn < 24) || (pn >= 40 && pn < 48) || (pn >= 72)) run<2>(acc, u, wr, wc, fr, fq, false);
        else if (pn < 28) run<3>(acc, u, wr, wc, fr, fq, false);
        else run<0>(acc, u, wr, wc, fr, fq, false);
    }
};
struct EpiGate {
    static constexpr bool PERM = true;
    bf16_t* G; const float* bias;
    __device__ __forceinline__ void operator()(const f32x4 (&acc)[2][2][4][2], const Unit& u, int wr, int wc, int fr, int fq) const {
        const int row0 = u.pm * BM + wr * 64 + fr; const int col0 = u.pn * BM + wc * 32 + 8 * fq;
        f32x4 bv[2][2];
#pragma unroll
        for (int bj = 0; bj < 2; ++bj)
#pragma unroll
            for (int n = 0; n < 2; ++n) bv[bj][n] = *(const f32x4*)(bias + col0 + bj * HALF + 4 * n);
#pragma unroll
        for (int ai = 0; ai < 2; ++ai)
#pragma unroll
            for (int m = 0; m < 4; ++m) { bf16_t* rowp = G + (size_t)(row0 + ai * HALF + m * 16) * DM + col0;
#pragma unroll
                for (int bj = 0; bj < 2; ++bj) { f32x4 v0 = acc[ai][bj][m][0] + bv[bj][0], v1 = acc[ai][bj][m][1] + bv[bj][1];
#pragma unroll
                    for (int j = 0; j < 4; ++j) { v0[j] = sigmoidf_(v0[j]); v1[j] = sigmoidf_(v1[j]); }
                    u32x4 w; w.x = cvt_pk_bf16(v0[0], v0[1]); w.y = cvt_pk_bf16(v0[2], v0[3]); w.z = cvt_pk_bf16(v1[0], v1[1]); w.w = cvt_pk_bf16(v1[2], v1[3]);
                    *(u32x4*)(rowp + bj * HALF) = w; } }
    }
};
struct EpiBranch {
    static constexpr bool PERM = true;
    const bf16_t* G; const bf16_t* mfi; bf16_t* mfo; int mode;
    __device__ __forceinline__ void operator()(const f32x4 (&acc)[2][2][4][2], const Unit& u, int wr, int wc, int fr, int fq) const {
        const int row0 = u.pm * BM + wr * 64 + fr; const int col0 = u.pn * BM + wc * 32 + 8 * fq;
#pragma unroll
        for (int ai = 0; ai < 2; ++ai)
#pragma unroll
            for (int m = 0; m < 4; ++m) { const size_t off = (size_t)(row0 + ai * HALF + m * 16) * DM + col0;
#pragma unroll
                for (int bj = 0; bj < 2; ++bj) { const size_t o2 = off + bj * HALF;
                    const u32x4 gw = *(const u32x4*)(G + o2);
                    f32x4 v0 = acc[ai][bj][m][0], v1 = acc[ai][bj][m][1];
                    v0[0] *= bflo(gw.x); v0[1] *= bfhi(gw.x); v0[2] *= bflo(gw.y); v0[3] *= bfhi(gw.y);
                    v1[0] *= bflo(gw.z); v1[1] *= bfhi(gw.z); v1[2] *= bflo(gw.w); v1[3] *= bfhi(gw.w);
                    if (mode > 0) { const u32x4 pw = *(const u32x4*)(mfi + o2);
                        v0[0] += bflo(pw.x); v0[1] += bfhi(pw.x); v0[2] += bflo(pw.y); v0[3] += bfhi(pw.y);
                        v1[0] += bflo(pw.z); v1[1] += bfhi(pw.z); v1[2] += bflo(pw.w); v1[3] += bfhi(pw.w); }
                    u32x4 w; w.x = cvt_pk_bf16(v0[0], v0[1]); w.y = cvt_pk_bf16(v0[2], v0[3]); w.z = cvt_pk_bf16(v1[0], v1[1]); w.w = cvt_pk_bf16(v1[2], v1[3]);
                    *(u32x4*)(mfo + o2) = w; } }
    }
};
}

#define LBAR() do { asm volatile("s_waitcnt lgkmcnt(0)" ::: "memory"); __builtin_amdgcn_s_barrier(); asm volatile("" ::: "memory"); } while (0)
namespace att {
constexpr int D = 128, NW = 8, QBLK = 32, KVBLK = 64;
constexpr float SCALE = 0.088388347648318440f;
constexpr float THR = 8.f;
#ifndef ATT_SDEPTH
#define ATT_SDEPTH 1
#endif
constexpr int SDEPTH = ATT_SDEPTH;
constexpr int LDQ = LDP, LDK = LDP, LDO = DM;
constexpr size_t SHM_V = KVBLK * D * 2, SHM_K = KVBLK * D * 2;
constexpr size_t TB_OFF = 2 * SHM_V + 2 * SHM_K + NW * 64 * 4;
constexpr size_t Q_OFF = TB_OFF + 2048;
#define KSWZ(row, colB) ((row) * 256 + ((colB) ^ (((row) & 7) << 4)))
#define SBAR() __builtin_amdgcn_sched_barrier(0)
__device__ __forceinline__ int crow(int r, int hi) { return (r & 3) + 8 * (r >> 2) + 4 * hi; }
__device__ __forceinline__ unsigned cvtpk(float lo, float hi) { return cvt_pk_bf16(lo, hi); }

__device__ __forceinline__ void partialSM(f32x16& p0, f32x16& p1, float& m_reg, float& mn, float& alpha) {
  constexpr float C = SCALE * 1.4426950408889634f;
  float pmax = p0[0]; for (int r = 1; r < 16; ++r) pmax = fmaxf(pmax, p0[r]); for (int r = 0; r < 16; ++r) pmax = fmaxf(pmax, p1[r]);
  { auto rr = __builtin_amdgcn_permlane32_swap(__float_as_uint(pmax), __float_as_uint(pmax), false, false);
    pmax = fmaxf(__uint_as_float(rr[0]), __uint_as_float(rr[1])); }
  if (__builtin_expect(__all(pmax - m_reg <= THR / SCALE), 1)) { mn = m_reg; alpha = 1.f; }
  else { mn = fmaxf(m_reg, pmax); alpha = __builtin_amdgcn_exp2f((m_reg - mn) * C); m_reg = mn; }
  float mnC = -mn * C;
  for (int r = 0; r < 16; ++r) p0[r] = fmaf(p0[r], C, mnC); for (int r = 0; r < 16; ++r) p1[r] = fmaf(p1[r], C, mnC);
  for (int r = 0; r < 16; ++r) p0[r] = __builtin_amdgcn_exp2f(p0[r]);
}
__device__ __forceinline__ void finishSM(f32x16& p0, f32x16& p1, float alpha, float& l_reg, bf16x8& pa0, bf16x8& pa1, bf16x8& pa2, bf16x8& pa3) {
  for (int r = 0; r < 16; ++r) p1[r] = __builtin_amdgcn_exp2f(p1[r]);
  float ps = 0; for (int r = 0; r < 16; ++r) ps += p0[r]; for (int r = 0; r < 16; ++r) ps += p1[r];
  { auto rr = __builtin_amdgcn_permlane32_swap(__float_as_uint(ps), __float_as_uint(ps), false, false);
    ps = __uint_as_float(rr[0]) + __uint_as_float(rr[1]); }
  l_reg = l_reg * alpha + ps;
#define PK4(P, BASE, OUT) do { unsigned a0 = cvtpk(P[BASE + 0], P[BASE + 1]), a1 = cvtpk(P[BASE + 2], P[BASE + 3]);   \
    unsigned b0 = cvtpk(P[BASE + 4], P[BASE + 5]), b1 = cvtpk(P[BASE + 6], P[BASE + 7]);                              \
    auto r0 = __builtin_amdgcn_permlane32_swap(a0, b0, false, false); auto r1 = __builtin_amdgcn_permlane32_swap(a1, b1, false, false); \
    u32x4 w = {r0[0], r1[0], r0[1], r1[1]}; OUT = *reinterpret_cast<bf16x8*>(&w); } while (0)
  PK4(p0, 0, pa0); PK4(p0, 8, pa1); PK4(p1, 0, pa2); PK4(p1, 8, pa3);
#undef PK4
}
__device__ __forceinline__ void qkt(f32x16& p0, f32x16& p1, const bf16_t* Ks, const char* Qs, int qrow, int r32, int hi, int relw, const float* tb_l, float cL, float cR) {
  const bool farL = (relw + 63 <= -91), farR = (relw - 31 >= 91);
  const float ini = farL ? cL : (farR ? cR : 0.f);
  for (int r = 0; r < 16; ++r) { p0[r] = ini; p1[r] = ini; }
  for (int d0 = 0; d0 < 8; ++d0) { int cb = (d0 * 16 + hi * 8) * 2;
    bf16x8 b0 = *reinterpret_cast<const bf16x8*>((const char*)Ks + KSWZ(r32, cb));
    bf16x8 b1 = *reinterpret_cast<const bf16x8*>((const char*)Ks + KSWZ(32 + r32, cb));
    const bf16x8 qv = *reinterpret_cast<const bf16x8*>(Qs + KSWZ(qrow, cb));
    p0 = __builtin_amdgcn_mfma_f32_32x32x16_bf16(b0, qv, p0, 0, 0, 0);
    p1 = __builtin_amdgcn_mfma_f32_32x32x16_bf16(b1, qv, p1, 0, 0, 0); }
  if (!(farL || farR)) {
    const int rel0 = relw - r32 + 128;
#pragma unroll
    for (int r = 0; r < 16; ++r) { int i0 = rel0 + crow(r, hi); int i1 = i0 + 32;
      i0 = min(max(i0, 0), 256); i1 = min(max(i1, 0), 256);
      p0[r] += tb_l[i0]; p1[r] += tb_l[i1]; }
  }
}
__device__ __forceinline__ int v_st(int k, int c) { const int kk = (k & ~0xC) | ((k & 4) << 1) | ((k & 8) >> 1); return ((kk >> 3) * 4 + (c >> 5)) * 512 + ((kk & 7) * 32 + (c & 31)) * 2; }
__device__ __forceinline__ int v_rd_base(int lane) { return ((lane & 3) << 3) | (((lane >> 2) & 3) << 6) | (((lane >> 4) & 1) << 5) | (((lane >> 5) & 1) << 8); }
constexpr int v_rd_off(int d0, int ks, int half) { return d0 * 512 + ks * 4096 + half * 2048; }
template <int OFF> __device__ __forceinline__ s16x4 tr_read(int vb) {
  s16x4 r; asm volatile("ds_read_b64_tr_b16 %0, %1 offset:%2" : "=&v"(r) : "v"(vb), "i"(OFF) : "memory"); return r;
}
template <int D0> __device__ __forceinline__ void pv_one(f32x16& od, int vb, bf16x8 pa0, bf16x8 pa1, bf16x8 pa2, bf16x8 pa3) {
  const s16x4 l0 = tr_read<v_rd_off(D0, 0, 0)>(vb), h0 = tr_read<v_rd_off(D0, 0, 1)>(vb), l1 = tr_read<v_rd_off(D0, 1, 0)>(vb), h1 = tr_read<v_rd_off(D0, 1, 1)>(vb);
  const s16x4 l2 = tr_read<v_rd_off(D0, 2, 0)>(vb), h2 = tr_read<v_rd_off(D0, 2, 1)>(vb), l3 = tr_read<v_rd_off(D0, 3, 0)>(vb), h3 = tr_read<v_rd_off(D0, 3, 1)>(vb);
  asm volatile("s_waitcnt lgkmcnt(0)" ::: "memory"); SBAR();
#define PK(L, H) (bf16x8){L[0], L[1], L[2], L[3], H[0], H[1], H[2], H[3]}
  od = __builtin_amdgcn_mfma_f32_32x32x16_bf16(pa0, PK(l0, h0), od, 0, 0, 0);
  od = __builtin_amdgcn_mfma_f32_32x32x16_bf16(pa1, PK(l1, h1), od, 0, 0, 0);
  od = __builtin_amdgcn_mfma_f32_32x32x16_bf16(pa2, PK(l2, h2), od, 0, 0, 0);
  od = __builtin_amdgcn_mfma_f32_32x32x16_bf16(pa3, PK(l3, h3), od, 0, 0, 0);
#undef PK
}
__device__ __forceinline__ void pv_d0(f32x16* o, int vb, bf16x8 pa0, bf16x8 pa1, bf16x8 pa2, bf16x8 pa3) {
  pv_one<0>(o[0], vb, pa0, pa1, pa2, pa3); pv_one<1>(o[1], vb, pa0, pa1, pa2, pa3); pv_one<2>(o[2], vb, pa0, pa1, pa2, pa3); pv_one<3>(o[3], vb, pa0, pa1, pa2, pa3);
}

__device__ __forceinline__ void attn_body(const bf16_t* __restrict__ Qb, const bf16_t* __restrict__ Kh, const bf16_t* __restrict__ Vh,
                                          bf16_t* __restrict__ Ob, int seq, char* lds, int q0, const float* __restrict__ tbg, const int tid) {
  const int wid = tid >> 6, lane = tid & 63, r32 = lane & 31, hi = lane >> 5;
  bf16_t* V_lds = (bf16_t*)lds; bf16_t* K_lds = (bf16_t*)(lds + 2 * SHM_V);
  float* ws = (float*)(lds + 2 * SHM_V + 2 * SHM_K) + wid * 64; float* li_l = ws; float* al_l = ws + 32;
  float* tb_l = (float*)(lds + TB_OFF);
  __syncthreads();
  if (tid < 257) tb_l[tid] = tbg[tid];
  const float cL = tbg[0], cR = tbg[256];
  const int q0w = q0 + wid * QBLK;
  float m_reg = -1e30f, l_reg = 0; f32x16 o[4] = {};
  const char* Qs = lds + Q_OFF + (wid >> 1) * 16384; const int qrow = (wid & 1) * 32 + r32;
  { const bf16_t* Qw = Qb + (long)(wid * QBLK + r32) * LDQ + hi * 8;
#pragma unroll
    for (int d0 = 0; d0 < 8; ++d0) { const bf16x8 t = *reinterpret_cast<const bf16x8*>(Qw + d0 * 16); *(bf16x8*)(const_cast<char*>(Qs) + KSWZ(qrow, (d0 * 16 + hi * 8) * 2)) = t; } }
  const int sr = tid >> 4, sc = (tid & 15) * 8, vst0 = v_st(sr, sc), vst1 = v_st(32 + sr, sc);
  const int vb0 = (int)(uintptr_t)V_lds + v_rd_base(lane);
  struct { bf16x8 vs0, vs1, ks0, ks1; } sr_[SDEPTH];
#define SLOAD(i, k0) do { sr_[i].vs0 = *(const bf16x8*)(&Vh[(long)((k0) + sr) * LDK + sc]); sr_[i].vs1 = *(const bf16x8*)(&Vh[(long)((k0) + 32 + sr) * LDK + sc]); \
    sr_[i].ks0 = *(const bf16x8*)(&Kh[(long)((k0) + sr) * LDK + sc]); sr_[i].ks1 = *(const bf16x8*)(&Kh[(long)((k0) + 32 + sr) * LDK + sc]); } while (0)
#define SWRITE(b, i) do { *(bf16x8*)((char*)V_lds + (b) * SHM_V + vst0) = sr_[i].vs0;          \
    *(bf16x8*)((char*)V_lds + (b) * SHM_V + vst1) = sr_[i].vs1; int kc = sc * 2;               \
    *(bf16x8*)((char*)K_lds + (b) * SHM_K + KSWZ(sr, kc)) = sr_[i].ks0;                       \
    *(bf16x8*)((char*)K_lds + (b) * SHM_K + KSWZ(32 + sr, kc)) = sr_[i].ks1; } while (0)
#define SWAIT() do { if constexpr (SDEPTH == 2) asm volatile("s_waitcnt vmcnt(4)" ::: "memory"); else asm volatile("s_waitcnt vmcnt(0)" ::: "memory"); } while (0)
#define RESC(a) do { if (__any((a) < 1.f)) { if (hi == 0) al_l[r32] = (a); asm volatile("s_waitcnt lgkmcnt(0)" ::: "memory"); \
    for (int d = 0; d < 4; ++d) for (int r = 0; r < 16; ++r) o[d][r] *= al_l[crow(r, hi)]; } } while (0)
  f32x16 pA0, pA1, pB0, pB1; float mnA, mnB, alA, alB; bf16x8 pa0, pa1, pa2, pa3; const int NT = seq / KVBLK;
  constexpr int SE = 0, SO = SDEPTH - 1;
  SLOAD(SE, 0); asm volatile("s_waitcnt vmcnt(0)" ::: "memory"); SWRITE(0, SE); __syncthreads();
  qkt(pA0, pA1, K_lds, Qs, qrow, r32, hi, 0 - q0w, tb_l, cL, cR); partialSM(pA0, pA1, m_reg, mnA, alA);
  SLOAD(SO, KVBLK); if constexpr (SDEPTH == 2) { if (2 < NT) SLOAD(SE, 2 * KVBLK); }
  SWAIT(); SWRITE(1, SO); __syncthreads();
  for (int j = 1; j + 1 < NT; j += 2) {
    SBAR(); qkt(pB0, pB1, (bf16_t*)((char*)K_lds + SHM_K), Qs, qrow, r32, hi, j * KVBLK - q0w, tb_l, cL, cR);
    SBAR(); SLOAD(SO, (j + SDEPTH) * KVBLK); SBAR();
    finishSM(pA0, pA1, alA, l_reg, pa0, pa1, pa2, pa3); SBAR();
    pv_d0(o, vb0, pa0, pa1, pa2, pa3); partialSM(pB0, pB1, m_reg, mnB, alB);
    LBAR(); SWAIT(); SWRITE(0, SE);
    RESC(alB); LBAR();
    SBAR(); qkt(pA0, pA1, K_lds, Qs, qrow, r32, hi, (j + 1) * KVBLK - q0w, tb_l, cL, cR);
    SBAR(); if (SDEPTH == 1 || j + 3 < NT) SLOAD(SE, (j + 1 + SDEPTH) * KVBLK); SBAR();
    finishSM(pB0, pB1, alB, l_reg, pa0, pa1, pa2, pa3); SBAR();
    pv_d0(o, vb0 + (int)SHM_V, pa0, pa1, pa2, pa3); partialSM(pA0, pA1, m_reg, mnA, alA);
    LBAR(); SWAIT(); SWRITE(1, SO);
    RESC(alA); LBAR();
  }
  SBAR(); qkt(pB0, pB1, (bf16_t*)((char*)K_lds + SHM_K), Qs, qrow, r32, hi, (NT - 1) * KVBLK - q0w, tb_l, cL, cR);
  finishSM(pA0, pA1, alA, l_reg, pa0, pa1, pa2, pa3); SBAR();
  pv_d0(o, vb0, pa0, pa1, pa2, pa3); partialSM(pB0, pB1, m_reg, mnB, alB);
  __syncthreads(); RESC(alB);
  finishSM(pB0, pB1, alB, l_reg, pa0, pa1, pa2, pa3); SBAR();
  pv_d0(o, vb0 + (int)SHM_V, pa0, pa1, pa2, pa3);
  if (hi == 0) li_l[r32] = l_reg; asm volatile("s_waitcnt lgkmcnt(0)" ::: "memory");
  float rli[16];
#pragma unroll
  for (int r = 0; r < 16; ++r) rli[r] = __builtin_amdgcn_rcpf(li_l[crow(r, hi)]);
  bf16_t* Ow = Ob + (long)(wid * QBLK) * LDO;
#pragma unroll
  for (int r = 0; r < 16; ++r) { int orow = crow(r, hi);
#pragma unroll
    for (int d0 = 0; d0 < 4; ++d0) Ow[(long)orow * LDO + d0 * 32 + r32] = f2bf(o[d0][r] * rli[r]); }
#undef SLOAD
#undef SWRITE
#undef SWAIT
#undef RESC
}
}

struct Ctx {
    Args a; char* lds; int tid, lane, wid, G, bx, vcu;
};

__device__ __forceinline__ int srccol(int nd, int mode) {
    if (mode == 0) return nd;
    return nd < 12288 ? nd : (nd < 20480 ? nd + 32 : (nd < 20512 ? nd - 20480 + 12288 : -1));
}
__device__ __forceinline__ void wconv_job(const Ctx& c, const float* __restrict__ src0, int ld, bf16_t* __restrict__ dst0, int nd, int mode, int nbatch) {
    float* tile = (float*)c.lds;
    int tz = 0; asm volatile("" : "+v"(tz));
    const int tid = c.tid + tz;
    const int ntn = nd / 256, ntb = ntn * 32, ntiles = ntb * nbatch;
    f32x4 v[8];
#define WC_LOAD(t) do { const int bi_ = (t) / ntb, tr_ = (t) - bi_ * ntb; const float* src = src0 + (size_t)bi_ * 2048 * ld; const int tn_ = tr_ % ntn, tk_ = tr_ / ntn; _Pragma("unroll") for (int it = 0; it < 8; ++it) { const int idx = it * NTHR + tid; const int kk = idx >> 6, nn4 = (idx & 63) * 4; \
        const int sc = srccol(tn_ * 256 + nn4, mode); v[it] = (f32x4){0.f, 0.f, 0.f, 0.f}; if (sc >= 0) v[it] = __builtin_nontemporal_load((const f32x4*)(src + (size_t)(tk_ * 64 + kk) * ld + sc)); } } while (0)
    int t = c.bx;
    if (t < ntiles) WC_LOAD(t);
    for (; t < ntiles; t += c.G) {
#pragma unroll
        for (int it = 0; it < 8; ++it) { const int idx = it * NTHR + tid; const int kk = idx >> 6, nn4 = (idx & 63) * 4; *(f32x4*)(tile + kk * 260 + nn4) = v[it]; }
        __syncthreads();
        if (t + c.G < ntiles) WC_LOAD(t + c.G);
        {
            const int bi = t / ntb, tr = t - bi * ntb; const int tn = tr % ntn, tk = tr / ntn;
            const int nn = tid >> 1, kh = tid & 1;
            bf16_t* dp = dst0 + (size_t)bi * nd * 2048 + (size_t)(tn * 256 + nn) * 2048 + tk * 64 + kh * 32;
#pragma unroll
            for (int q = 0; q < 4; ++q) {
                float x[8];
#pragma unroll
                for (int j = 0; j < 8; ++j) x[j] = tile[(kh * 32 + q * 8 + j) * 260 + nn];
                u32x4 w; w.x = cvt_pk_bf16(x[0], x[1]); w.y = cvt_pk_bf16(x[2], x[3]); w.z = cvt_pk_bf16(x[4], x[5]); w.w = cvt_pk_bf16(x[6], x[7]);
                *(u32x4*)(dp + q * 8) = w;
            }
        }
        __syncthreads();
    }
#undef WC_LOAD
}

__device__ __forceinline__ void wconv_super(const Ctx& c, int l, int u) {
    float* tile = (float*)c.lds;
    int tz = 0; asm volatile("" : "+v"(tz));
    const int tid = c.tid + tz;
    const float* src; bf16_t* dst; int ld, ntn, t;
    if (u < 768) { src = c.a.w_merge + (size_t)l * 2048 * 6144; ld = 6144; ntn = 24; t = u; dst = (bf16_t*)(c.a.ws + WS_WM); }
    else if (u < 1536) { const int bi = (u - 768) >> 8; src = c.a.w_branch + (size_t)(l * 3 + bi) * 2048 * 2048; ld = 2048; ntn = 8; t = (u - 768) & 255; dst = (bf16_t*)(c.a.ws + WS_WB) + (size_t)bi * 2048 * 2048; }
    else { src = c.a.w_out + (size_t)l * 2048 * 2048; ld = 2048; ntn = 8; t = u - 1536; dst = (bf16_t*)(c.a.ws + WS_WO); }
    const int tn = t % ntn, tk = t / ntn;
    f32x4 v[8];
#pragma unroll
    for (int it = 0; it < 8; ++it) { const int idx = it * NTHR + tid; const int kk = idx >> 6, nn4 = (idx & 63) * 4; v[it] = __builtin_nontemporal_load((const f32x4*)(src + (size_t)(tk * 64 + kk) * ld + tn * 256 + nn4)); }
#pragma unroll
    for (int it = 0; it < 8; ++it) { const int idx = it * NTHR + tid; const int kk = idx >> 6, nn4 = (idx & 63) * 4; *(f32x4*)(tile + kk * 260 + nn4) = v[it]; }
    __syncthreads();
    {
        const int nn = tid >> 1, kh = tid & 1;
        bf16_t* dp = dst + (size_t)(tn * 256 + nn) * 2048 + tk * 64 + kh * 32;
#pragma unroll
        for (int q = 0; q < 4; ++q) {
            float x[8];
#pragma unroll
            for (int j = 0; j < 8; ++j) x[j] = tile[(kh * 32 + q * 8 + j) * 260 + nn];
            u32x4 w; w.x = cvt_pk_bf16(x[0], x[1]); w.y = cvt_pk_bf16(x[2], x[3]); w.z = cvt_pk_bf16(x[4], x[5]); w.w = cvt_pk_bf16(x[6], x[7]);
            *(u32x4*)(dp + q * 8) = w;
        }
    }
    __syncthreads();
}

__device__ __forceinline__ void row_pass(const Ctx& c, int mode, const float* gpre, const float* gpost) {
    const float* xin = (mode == 2) ? c.a.out : c.a.x;
    const bf16_t* outf = (const bf16_t*)(c.a.ws + WS_OUTF);
    bf16_t* H = (bf16_t*)(c.a.ws + WS_H);
    for (int row = c.bx * 8 + c.wid; row < MT; row += c.G * 8) {
        f32x4 xv[8];
        const size_t base = (size_t)row * DM;
#pragma unroll
        for (int it = 0; it < 8; ++it) xv[it] = __builtin_nontemporal_load((const f32x4*)(xin + base + it * 256 + c.lane * 4));
        if (mode != 0) {
            f32x4 ov[8]; float ss = 0.f;
#pragma unroll
            for (int it = 0; it < 8; ++it) { const u32x2 rw = __builtin_nontemporal_load((const u32x2*)(outf + base + it * 256 + c.lane * 4)); ov[it] = (f32x4){bflo(rw.x), bfhi(rw.x), bflo(rw.y), bfhi(rw.y)}; ss += ov[it][0] * ov[it][0] + ov[it][1] * ov[it][1] + ov[it][2] * ov[it][2] + ov[it][3] * ov[it][3]; }
            ss = wave_sum(ss); const float ri = rsqrtf(ss * (1.f / DM) + EPS);
#pragma unroll
            for (int it = 0; it < 8; ++it) { const f32x4 gp = *(const f32x4*)(gpost + it * 256 + c.lane * 4); xv[it] += ov[it] * ri * gp; __builtin_nontemporal_store(xv[it], (f32x4*)(c.a.out + base + it * 256 + c.lane * 4)); }
        }
        if (mode != 2) {
            float ss = 0.f;
#pragma unroll
            for (int it = 0; it < 8; ++it) ss += xv[it][0] * xv[it][0] + xv[it][1] * xv[it][1] + xv[it][2] * xv[it][2] + xv[it][3] * xv[it][3];
            ss = wave_sum(ss); const float ri = rsqrtf(ss * (1.f / DM) + EPS);
#pragma unroll
            for (int it = 0; it < 8; ++it) { const f32x4 g = *(const f32x4*)(gpre + it * 256 + c.lane * 4); const f32x4 hv = xv[it] * ri * g;
                u32x2 w; w.x = cvt_pk_bf16(hv[0], hv[1]); w.y = cvt_pk_bf16(hv[2], hv[3]); *(u32x2*)(H + base + it * 256 + c.lane * 4) = w; }
        }
    }
}

__device__ __forceinline__ void bias_table(const Ctx& c) {
    float* tb = (float*)(c.a.ws + WS_TB);
    for (int e = c.tid; e < 8 * 257; e += NTHR) {
        const int h = e / 257, idx = e % 257, rel = idx - 128;
        const int n = rel < 0 ? -rel : rel; const int ret = rel > 0 ? 16 : 0;
        const float nf = (float)(n > 1 ? n : 1);
        int large = 8 + (int)(logf(nf / 8.f) / 2.772588722239781f * 8.f);
        large = large < 15 ? large : 15;
        const int bucket = ret + (n < 8 ? n : large);
        tb[h * 260 + idx] = c.a.rel_bias[bucket * 8 + h] * (1.f / att::SCALE);
    }
}

constexpr int G_QA = 0, G_KB = 33792, G_KBT = 67584, G_VT = 104448, G_SC = 122880, G_LR = 132096, G_QS = 136192, G_ER = 140288, G_CC = 141312;
template <int OFF> __device__ __forceinline__ u32x4 lds_rd128(int addr) { u32x4 r; asm volatile("ds_read_b128 %0, %1 offset:%2" : "=&v"(r) : "v"(addr), "i"(OFF) : "memory"); return r; }
template <int OFF> __device__ __forceinline__ f32x4 lds_rdf(int addr) { f32x4 r; asm volatile("ds_read_b128 %0, %1 offset:%2" : "=&v"(r) : "v"(addr), "i"(OFF) : "memory"); return r; }
template <int OFF> __device__ __forceinline__ u32x2 lds_rd64(int addr) { u32x2 r; asm volatile("ds_read_b64 %0, %1 offset:%2" : "=&v"(r) : "v"(addr), "i"(OFF) : "memory"); return r; }
#define LWAIT() do { asm volatile("s_waitcnt lgkmcnt(0)" ::: "memory"); __builtin_amdgcn_sched_barrier(0); } while (0)
#define AS8(x) (*reinterpret_cast<const bf16x8*>(&(x)))
__device__ __forceinline__ bf16x8 pka_(u32x2 lo, u32x2 hi) { u32x4 w; w.x = lo.x; w.y = lo.y; w.z = hi.x; w.w = hi.y; return *reinterpret_cast<bf16x8*>(&w); }
#define PKA(l, h) pka_(l, h)
constexpr int A2_K0 = 0, A2_K1 = 17408, A2_V0 = 34816, A2_V1 = 71680, A2_TB = 108544;
__device__ __forceinline__ void attn2_item(const Ctx& c, int b, int h, int map, int qb) {
    char* lds = c.lds;
    const bf16_t* P = (const bf16_t*)(c.a.ws + WS_P);
    const bf16_t* Kh = P + (size_t)(b * SEQ) * LDP + C_CK + h * 256 + map * 128;
    const bf16_t* Vh = P + (size_t)(b * SEQ) * LDP + C_CV + h * 256;
    constexpr float SC = att::SCALE, C2 = att::SCALE * 1.4426950408889634f, THRR = att::THR / att::SCALE;
    int az = 0; asm volatile("" : "+v"(az));
    const int tid = c.tid + az, lane = tid & 63, w = c.wid, m16 = lane & 15, g4 = lane >> 4;
    const int q0w = qb * 128 + w * 16;
    float* tb_l = (float*)(lds + A2_TB);
    __syncthreads();
    if (tid < 257) {
        const int rel = tid - 128; const int n = rel < 0 ? -rel : rel; const int ret = rel > 0 ? 16 : 0;
        const float nf = (float)(n > 1 ? n : 1);
        int large = 8 + (int)(logf(nf / 8.f) / 2.772588722239781f * 8.f);
        large = large < 15 ? large : 15;
        const int bucket = ret + (n < 8 ? n : large);
        tb_l[tid] = c.a.rel_bias[bucket * 8 + h] * (1.f / SC);
    }
    const float cL = c.a.rel_bias[15 * 8 + h] * (1.f / SC), cR = c.a.rel_bias[31 * 8 + h] * (1.f / SC);
    bf16x8 qreg[4];
    {
        const bf16_t* Qw = P + (size_t)(b * SEQ + q0w + m16) * LDP + C_CQ + h * 256 + map * 128 + 8 * g4;
#pragma unroll
        for (int ks = 0; ks < 4; ++ks) qreg[ks] = *(const bf16x8*)(Qw + 32 * ks);
    }
    f32x4 o[16];
#pragma unroll
    for (int vt = 0; vt < 16; ++vt) o[vt] = (f32x4){0.f, 0.f, 0.f, 0.f};
    float m_reg = -1e30f, l_reg = 0.f;
    u32x4 sk[2][2]; unsigned sv[2][16];
#define A2_LOAD(sl, k0) do { _Pragma("unroll") for (int it = 0; it < 2; ++it) { const int v = it * NTHR + tid; sk[sl][it] = *(const u32x4*)(Kh + (size_t)((k0) + (v >> 4)) * LDP + (v & 15) * 8); } \
        _Pragma("unroll") for (int it = 0; it < 2; ++it) { const int u = it * NTHR + tid; const int cp = u & 127, kg = u >> 7; const bf16_t* vp = Vh + (size_t)((k0) + kg * 8) * LDP + 2 * cp; \
            _Pragma("unroll") for (int x = 0; x < 8; ++x) sv[sl][it * 8 + x] = *(const unsigned*)(vp + (size_t)x * LDP); } } while (0)
#define A2_LO2(x, y) __builtin_amdgcn_perm((y), (x), 0x05040100u)
#define A2_HI2(x, y) __builtin_amdgcn_perm((y), (x), 0x07060302u)
#define A2_WRITE(sl, buf) do { char* kb_ = lds + ((buf) ? A2_K1 : A2_K0); char* vb_ = lds + ((buf) ? A2_V1 : A2_V0); \
        _Pragma("unroll") for (int it = 0; it < 2; ++it) { const int v = it * NTHR + tid; *(u32x4*)(kb_ + (v >> 4) * 272 + (v & 15) * 16) = sk[sl][it]; } \
        _Pragma("unroll") for (int it = 0; it < 2; ++it) { const int u = it * NTHR + tid; const int cp = u & 127, kg = u >> 7; u32x4 a_, b_; \
            a_.x = A2_LO2(sv[sl][it * 8 + 0], sv[sl][it * 8 + 1]); a_.y = A2_LO2(sv[sl][it * 8 + 2], sv[sl][it * 8 + 3]); a_.z = A2_LO2(sv[sl][it * 8 + 4], sv[sl][it * 8 + 5]); a_.w = A2_LO2(sv[sl][it * 8 + 6], sv[sl][it * 8 + 7]); \
            b_.x = A2_HI2(sv[sl][it * 8 + 0], sv[sl][it * 8 + 1]); b_.y = A2_HI2(sv[sl][it * 8 + 2], sv[sl][it * 8 + 3]); b_.z = A2_HI2(sv[sl][it * 8 + 4], sv[sl][it * 8 + 5]); b_.w = A2_HI2(sv[sl][it * 8 + 6], sv[sl][it * 8 + 7]); \
            *(u32x4*)(vb_ + cp * 144 + kg * 16) = a_; *(u32x4*)(vb_ + (128 + cp) * 144 + kg * 16) = b_; } } while (0)
    A2_LOAD(0, 0);
    A2_WRITE(0, 0);
    LBAR();
    A2_LOAD(0, 64); A2_LOAD(1, 128);
    for (int j2 = 0; j2 < 32; j2 += 2) {
#pragma unroll
      for (int half = 0; half < 2; ++half) {
        const int j = j2 + half, buf = half;
        __builtin_amdgcn_sched_barrier(0);
        const int bK = (int)(uintptr_t)(lds + (buf ? A2_K1 : A2_K0)) + m16 * 272 + g4 * 16;
        const int bV = (int)(uintptr_t)(lds + (buf ? A2_V1 : A2_V0)) + m16 * 144 + g4 * 8;
        const int relw = j * 64 - q0w;
        const bool farL = (relw + 63 <= -91), farR = (relw - 15 >= 91);
        const float ini = farL ? cL : (farR ? cR : 0.f);
        f32x4 p[4];
#pragma unroll
        for (int kt = 0; kt < 4; ++kt) p[kt] = (f32x4){0.f, 0.f, 0.f, 0.f};
#define A2_KR(kt, ks) lds_rd128<(kt) * 4352 + (ks) * 64>(bK)
#define A2_MK(kt, ks, A) p[kt] = __builtin_amdgcn_mfma_f32_16x16x32_bf16(AS8(A), qreg[ks], p[kt], 0, 0, 0)
        {
            const u32x4 a00 = A2_KR(0, 0), a01 = A2_KR(0, 1), a02 = A2_KR(0, 2), a03 = A2_KR(0, 3), a10 = A2_KR(1, 0), a11 = A2_KR(1, 1), a12 = A2_KR(1, 2), a13 = A2_KR(1, 3);
            LWAIT();
            A2_MK(0, 0, a00); A2_MK(1, 0, a10); A2_MK(0, 1, a01); A2_MK(1, 1, a11); A2_MK(0, 2, a02); A2_MK(1, 2, a12); A2_MK(0, 3, a03); A2_MK(1, 3, a13);
        }
        {
            const u32x4 a20 = A2_KR(2, 0), a21 = A2_KR(2, 1), a22 = A2_KR(2, 2), a23 = A2_KR(2, 3), a30 = A2_KR(3, 0), a31 = A2_KR(3, 1), a32 = A2_KR(3, 2), a33 = A2_KR(3, 3);
            LWAIT();
            A2_MK(2, 0, a20); A2_MK(3, 0, a30); A2_MK(2, 1, a21); A2_MK(3, 1, a31); A2_MK(2, 2, a22); A2_MK(3, 2, a32); A2_MK(2, 3, a23); A2_MK(3, 3, a33);
        }
#undef A2_KR
#undef A2_MK
#define A2_VR(vt, kt) lds_rd64<(vt) * 2304 + (kt) * 32>(bV)
#define A2_VLOAD(P_, vt0) \
        const u32x2 P_##00 = A2_VR((vt0) + 0, 0), P_##01 = A2_VR((vt0) + 0, 1), P_##02 = A2_VR((vt0) + 0, 2), P_##03 = A2_VR((vt0) + 0, 3), P_##10 = A2_VR((vt0) + 1, 0), P_##11 = A2_VR((vt0) + 1, 1), P_##12 = A2_VR((vt0) + 1, 2), P_##13 = A2_VR((vt0) + 1, 3); \
        const u32x2 P_##20 = A2_VR((vt0) + 2, 0), P_##21 = A2_VR((vt0) + 2, 1), P_##22 = A2_VR((vt0) + 2, 2), P_##23 = A2_VR((vt0) + 2, 3), P_##30 = A2_VR((vt0) + 3, 0), P_##31 = A2_VR((vt0) + 3, 1), P_##32 = A2_VR((vt0) + 3, 2), P_##33 = A2_VR((vt0) + 3, 3);
#define A2_MV0(vt, X0, X1) o[vt] = __builtin_amdgcn_mfma_f32_16x16x32_bf16(PKA(X0, X1), AS8(bw0), o[vt], 0, 0, 0)
#define A2_MV1(vt, X2, X3) o[vt] = __builtin_amdgcn_mfma_f32_16x16x32_bf16(PKA(X2, X3), AS8(bw1), o[vt], 0, 0, 0)
#define A2_VMMA(P_, vt0) do { A2_MV0((vt0) + 0, P_##00, P_##01); A2_MV0((vt0) + 1, P_##10, P_##11); A2_MV0((vt0) + 2, P_##20, P_##21); A2_MV0((vt0) + 3, P_##30, P_##31); \
        A2_MV1((vt0) + 0, P_##02, P_##03); A2_MV1((vt0) + 1, P_##12, P_##13); A2_MV1((vt0) + 2, P_##22, P_##23); A2_MV1((vt0) + 3, P_##32, P_##33); } while (0)
        A2_VLOAD(va, 0)
        if (!(farL || farR)) {
            const int rel0 = relw - m16 + 4 * g4 + 128;
#pragma unroll
            for (int kt = 0; kt < 4; ++kt)
#pragma unroll
                for (int r = 0; r < 4; ++r) { int ix = rel0 + 16 * kt + r; ix = min(max(ix, 0), 256); p[kt][r] += tb_l[ix]; }
        }
        float pmax = p[0][0];
#pragma unroll
        for (int kt = 0; kt < 4; ++kt)
#pragma unroll
            for (int r = 0; r < 4; ++r) pmax = fmaxf(pmax, p[kt][r]);
        { auto rr = __builtin_amdgcn_permlane16_swap(__float_as_uint(pmax), __float_as_uint(pmax), false, false); pmax = fmaxf(__uint_as_float(rr[0]), __uint_as_float(rr[1])); }
        { auto rr = __builtin_amdgcn_permlane32_swap(__float_as_uint(pmax), __float_as_uint(pmax), false, false); pmax = fmaxf(__uint_as_float(rr[0]), __uint_as_float(rr[1])); }
        pmax += ini;
        if (!__all(pmax - m_reg <= THRR)) {
            const float mn = fmaxf(m_reg, pmax); const float alpha = __builtin_amdgcn_exp2f((m_reg - mn) * C2); m_reg = mn;
            l_reg *= alpha;
#pragma unroll
            for (int vt = 0; vt < 16; ++vt) o[vt] *= alpha;
        }
        const float mnC = (ini - m_reg) * C2; float ps = 0.f;
#pragma unroll
        for (int kt = 0; kt < 4; ++kt)
#pragma unroll
            for (int r = 0; r < 4; ++r) { const float e = __builtin_amdgcn_exp2f(fmaf(p[kt][r], C2, mnC)); p[kt][r] = e; ps += e; }
        l_reg += ps;
        u32x4 bw0, bw1;
        bw0.x = cvt_pk_bf16(p[0][0], p[0][1]); bw0.y = cvt_pk_bf16(p[0][2], p[0][3]); bw0.z = cvt_pk_bf16(p[1][0], p[1][1]); bw0.w = cvt_pk_bf16(p[1][2], p[1][3]);
        bw1.x = cvt_pk_bf16(p[2][0], p[2][1]); bw1.y = cvt_pk_bf16(p[2][2], p[2][3]); bw1.z = cvt_pk_bf16(p[3][0], p[3][1]); bw1.w = cvt_pk_bf16(p[3][2], p[3][3]);
        LWAIT();
        A2_VMMA(va, 0);
        { A2_VLOAD(vb, 4) LWAIT(); A2_VMMA(vb, 4); }
        { A2_VLOAD(vc, 8) LWAIT(); A2_VMMA(vc, 8); }
        { A2_VLOAD(vd, 12) LWAIT(); A2_VMMA(vd, 12); }
#undef A2_VR
#undef A2_VLOAD
#undef A2_MV0
#undef A2_MV1
#undef A2_VMMA
        __builtin_amdgcn_sched_barrier(0);
        A2_WRITE(half, buf ^ 1);
        LBAR();
        { const int jn = (j + 3 < 32) ? j + 3 : 31; A2_LOAD(half, jn * 64); }
      }
    }
    l_reg += __shfl_xor(l_reg, 16); l_reg += __shfl_xor(l_reg, 32);
    const float rl = __builtin_amdgcn_rcpf(l_reg);
    bf16_t* Ob = (bf16_t*)(c.a.ws + WS_OA) + ((size_t)map * MT + b * SEQ + q0w + m16) * DM + h * 256 + 8 * g4;
#pragma unroll
    for (int vt = 0; vt < 8; ++vt) {
        u32x4 wv; wv.x = cvt_pk_bf16(o[vt][0] * rl, o[vt + 8][0] * rl); wv.y = cvt_pk_bf16(o[vt][1] * rl, o[vt + 8][1] * rl);
        wv.z = cvt_pk_bf16(o[vt][2] * rl, o[vt + 8][2] * rl); wv.w = cvt_pk_bf16(o[vt][3] * rl, o[vt + 8][3] * rl);
        __builtin_nontemporal_store(wv, (u32x4*)(Ob + 32 * vt));
    }
#undef A2_LOAD
#undef A2_WRITE
#undef A2_LO2
#undef A2_HI2
}

#define OPQ(v) ({ int _z = 0; asm volatile("" : "+v"(_z)); (v) + _z; })
#define GROW(nn, i) (b * SEQ + (dir ? (SEQ - 1 - ((nn) * 64 + (i))) : ((nn) * 64 + (i))))
__device__ __forceinline__ void gla_lr_block(const Ctx& c, int b, int nb) {
    char* lds = c.lds;
    const bf16_t* H = (const bf16_t*)(c.a.ws + WS_H) + (size_t)(b * SEQ + nb * 64) * DM;
    const bf16_t* WL = (const bf16_t*)(c.a.ws + WS_W) + (size_t)20480 * DM;
    const int w = c.wid; const int ln = OPQ(c.lane); const int m16 = ln & 15, g4 = ln >> 4;
    f32x4 acc[4][2];
#pragma unroll
    for (int rt = 0; rt < 4; ++rt) { acc[rt][0] = (f32x4){0.f, 0.f, 0.f, 0.f}; acc[rt][1] = (f32x4){0.f, 0.f, 0.f, 0.f}; }
#pragma unroll 2
    for (int ks = 0; ks < 8; ++ks) {
        const int k0 = 256 * w + 32 * ks + 8 * g4;
        const bf16x8 b0 = *(const bf16x8*)(WL + (size_t)m16 * DM + k0), b1 = *(const bf16x8*)(WL + (size_t)(16 + m16) * DM + k0);
#pragma unroll
        for (int rt = 0; rt < 4; ++rt) {
            const bf16x8 av = *(const bf16x8*)(H + (size_t)(rt * 16 + m16) * DM + k0);
            acc[rt][0] = __builtin_amdgcn_mfma_f32_16x16x32_bf16(av, b0, acc[rt][0], 0, 0, 0);
            acc[rt][1] = __builtin_amdgcn_mfma_f32_16x16x32_bf16(av, b1, acc[rt][1], 0, 0, 0);
        }
    }
    LBAR();
#pragma unroll
    for (int rt = 0; rt < 4; ++rt)
#pragma unroll
        for (int ct = 0; ct < 2; ++ct)
#pragma unroll
            for (int r = 0; r < 4; ++r) *(float*)(lds + G_QA + ((w * 64 + rt * 16 + 4 * g4 + r) * 32 + ct * 16 + m16) * 4) = acc[rt][ct][r];
    LBAR();
    {
        const int tc = OPQ(c.tid);
        f32x4 sacc = (f32x4){0.f, 0.f, 0.f, 0.f};
#pragma unroll
        for (int w2 = 0; w2 < 8; ++w2) sacc += *(const f32x4*)(lds + G_QA + (w2 * 2048 + tc * 4) * 4);
        *(f32x4*)(lds + G_VT + tc * 16) = sacc;
    }
    LBAR();
}

__device__ __forceinline__ void gla_pre_item(const Ctx& c, int l, int b, int h, int dir, int n) {
    char* lds = c.lds;
    const bf16_t* P = (const bf16_t*)(c.a.ws + WS_P);
    const int ci = ((b * 4 + h) * 2 + dir) * 32 + n;
    const int w = c.wid;
    const int te = OPQ(c.tid); const int dp = te & 127, qr = te >> 7;
    const int rstep = dir ? -LDP : LDP;
    unsigned rq[16], rk[16];
    {
        const bf16_t* Pn = P + (size_t)GROW(n, 0) * LDP; const int t0 = (C_BQ + h * 256 + 2 * dp) + 16 * qr * rstep;
#pragma unroll
        for (int i = 0; i < 16; ++i) { rq[i] = *(const unsigned*)(Pn + (t0 + i * rstep)); rk[i] = *(const unsigned*)(Pn + (t0 + i * rstep + (C_BK - C_BQ))); }
    }
    float wa0[16], wa1[16];
    {
        const float* wp = c.a.wa2 + ((size_t)(l * 2 + dir) * 16) * 1024 + h * 256 + 2 * dp;
#pragma unroll
        for (int r = 0; r < 16; ++r) { const f32x2 t = *(const f32x2*)(wp + r * 1024); wa0[r] = t.x; wa1[r] = t.y; }
    }
    const f32x2 bav = *(const f32x2*)(c.a.ba + (size_t)(l * 2 + dir) * 1024 + h * 256 + 2 * dp);
    LBAR();
    float cl0[16], cl1[16];
    {
        float run0 = 0.f, run1 = 0.f;
#pragma unroll
        for (int i = 0; i < 16; ++i) {
            const int ii = dir ? (63 - (16 * qr + i)) : (16 * qr + i);
            const float* lp = (const float*)(lds + G_VT) + ii * 32 + dir * 16;
            float z0 = bav.x, z1 = bav.y;
#pragma unroll
            for (int r4 = 0; r4 < 4; ++r4) { const f32x4 t = *(const f32x4*)(lp + 4 * r4);
#pragma unroll
                for (int j = 0; j < 4; ++j) { z0 = fmaf(t[j], wa0[4 * r4 + j], z0); z1 = fmaf(t[j], wa1[4 * r4 + j], z1); } }
            run0 += logsig(z0) * 0.0625f; run1 += logsig(z1) * 0.0625f; cl0[i] = run0; cl1[i] = run1;
        }
        *(f32x2*)(lds + G_QS + (qr * 256 + 2 * dp) * 4) = (f32x2){run0, run1};
    }
    LBAR();
    {
        const f32x2 s0 = *(const f32x2*)(lds + G_QS + (0 * 256 + 2 * dp) * 4), s1 = *(const f32x2*)(lds + G_QS + (1 * 256 + 2 * dp) * 4);
        const f32x2 s2 = *(const f32x2*)(lds + G_QS + (2 * 256 + 2 * dp) * 4), s3 = *(const f32x2*)(lds + G_QS + (3 * 256 + 2 * dp) * 4);
        const f32x2 ref = s0 + s1, last = ref + s2 + s3;
        f32x2 pre = (f32x2){0.f, 0.f};
        if (qr > 0) pre += s0; if (qr > 1) pre += s1; if (qr > 2) pre += s2;
#define LO2(x, y) (((x) & 0xffffu) | ((y) << 16))
#define HI2(x, y) (((x) >> 16) | ((y) & 0xffff0000u))
        const float er0 = __expf(ref.x), er1 = __expf(ref.y), cc0 = __expf(last.x - ref.x), cc1 = __expf(last.y - ref.y);
        unsigned char* gq = c.a.ws + WS_GQA + (size_t)ci * 32768; unsigned char* gk = c.a.ws + WS_GKT + (size_t)ci * 32768;
#pragma unroll
        for (int hf = 0; hf < 2; ++hf) {
            unsigned ks[8];
#pragma unroll
            for (int ii = 0; ii < 8; ++ii) {
                const int i = hf * 8 + ii;
                const float c0 = cl0[i] + pre.x, c1 = cl1[i] + pre.y;
                const float ea0 = __expf(c0 - ref.x), ea1 = __expf(c1 - ref.y), eb0 = __expf(ref.x - c0), eb1 = __expf(ref.y - c1);
                const float qa0 = bflo(rq[i]) * ea0, qa1 = bfhi(rq[i]) * ea1, kb0 = bflo(rk[i]) * eb0, kb1 = bfhi(rk[i]) * eb1;
                *(unsigned*)(lds + G_QA + (16 * qr + i) * 528 + dp * 4) = cvt_pk_bf16(qa0, qa1);
                *(unsigned*)(lds + G_KB + (16 * qr + i) * 528 + dp * 4) = cvt_pk_bf16(kb0, kb1);
                *(unsigned*)(gq + ((16 * qr + i) * 256 + 2 * dp) * 2) = cvt_pk_bf16(qa0 * er0, qa1 * er1);
                ks[ii] = cvt_pk_bf16(kb0 * cc0, kb1 * cc1);
            }
            u32x4 a0, b0;
            a0.x = LO2(ks[0], ks[1]); a0.y = LO2(ks[2], ks[3]); a0.z = LO2(ks[4], ks[5]); a0.w = LO2(ks[6], ks[7]);
            b0.x = HI2(ks[0], ks[1]); b0.y = HI2(ks[2], ks[3]); b0.z = HI2(ks[4], ks[5]); b0.w = HI2(ks[6], ks[7]);
            *(u32x4*)(gk + ((2 * dp) * 64 + 16 * qr + hf * 8) * 2) = a0;
            *(u32x4*)(gk + ((2 * dp + 1) * 64 + 16 * qr + hf * 8) * 2) = b0;
        }
#undef LO2
#undef HI2
        if (qr == 0) *(f32x2*)(lds + G_ER + 2 * dp * 4) = (f32x2){__expf(last.x), __expf(last.y)};
    }
    LBAR();
    {
        const int ln5 = OPQ(c.lane); const int m16 = ln5 & 15, g4 = ln5 >> 4;
#pragma unroll
        for (int s = 0; s < 2; ++s) {
            const int idx = 2 * w + s, ti = idx >> 2, tj = idx & 3;
            f32x4 cc = (f32x4){0.f, 0.f, 0.f, 0.f};
            if (tj <= ti) {
#pragma unroll
                for (int ks = 0; ks < 8; ++ks) {
                    const bf16x8 av = *(const bf16x8*)(lds + G_QA + (16 * ti + m16) * 528 + (32 * ks + 8 * g4) * 2);
                    const bf16x8 bv = *(const bf16x8*)(lds + G_KB + (16 * tj + m16) * 528 + (32 * ks + 8 * g4) * 2);
                    cc = __builtin_amdgcn_mfma_f32_16x16x32_bf16(av, bv, cc, 0, 0, 0);
                }
                if (ti == tj) {
#pragma unroll
                    for (int r = 0; r < 4; ++r) if (m16 > 4 * g4 + r) cc[r] = 0.f;
                }
            }
#pragma unroll
            for (int r = 0; r < 4; ++r) *(bf16_t*)(lds + G_SC + (16 * ti + 4 * g4 + r) * 144 + (16 * tj + m16) * 2) = f2bf(cc[r]);
        }
    }
    LBAR();
    {
        const int tc = OPQ(c.tid);
        *(u32x4*)(c.a.ws + WS_GSC + (size_t)ci * 8192 + tc * 16) = *(const u32x4*)(lds + G_SC + (tc >> 3) * 144 + (tc & 7) * 16);
        if (tc < 64) *(u32x4*)(c.a.ws + WS_GEC + (size_t)ci * 2048 + tc * 16) = *(const u32x4*)(lds + G_ER + tc * 16);
    }
}

__device__ __forceinline__ void gla_scan_item(const Ctx& c, int l, int b, int h, int dir, int dvs) {
    char* lds = c.lds;
    const bf16_t* P = (const bf16_t*)(c.a.ws + WS_P);
    bf16_t* og = (bf16_t*)(c.a.ws + WS_OG) + (size_t)dir * MT * DM;
    const int w = c.wid;
    const int ci0 = ((b * 4 + h) * 2 + dir) * 32;
    const int rstep = dir ? -LDP : LDP;
    f32x4 S[16];
#pragma unroll
    for (int t = 0; t < 16; ++t) S[t] = (f32x4){0.f, 0.f, 0.f, 0.f};
    u32x4 pq[4], pk[4], ps, pe; unsigned rv[8];
#define GS_LOAD(nn, tz) do { const int tc = c.tid + (tz); const size_t ci = (size_t)(ci0 + (nn)); \
        const unsigned char* gq = c.a.ws + WS_GQA + ci * 32768; const unsigned char* gk = c.a.ws + WS_GKT + ci * 32768; \
        _Pragma("unroll") for (int it = 0; it < 4; ++it) { pq[it] = *(const u32x4*)(gq + (it * NTHR + tc) * 16); pk[it] = *(const u32x4*)(gk + (it * NTHR + tc) * 16); } \
        ps = *(const u32x4*)(c.a.ws + WS_GSC + ci * 8192 + tc * 16); \
        pe = *(const u32x4*)(c.a.ws + WS_GEC + ci * 2048 + (tc & 63) * 16); \
        { const int ep = tc & 63, q8 = tc >> 6; const bf16_t* Pn = P + (size_t)GROW(nn, 0) * LDP; const int t0 = (C_BV + h * 512 + dvs * 128 + 2 * ep) + 8 * q8 * rstep; \
          _Pragma("unroll") for (int x = 0; x < 8; ++x) rv[x] = *(const unsigned*)(Pn + (t0 + x * rstep)); } } while (0)
    { int tz = 0; asm volatile("" : "+v"(tz)); GS_LOAD(0, tz); }
    for (int n = 0; n < 32; ++n) {
        int oz = 0; asm volatile("" : "+v"(oz));
        const int tc = c.tid + oz;
        LBAR();
        {
#pragma unroll
            for (int it = 0; it < 4; ++it) { const int v = it * NTHR + tc;
                *(u32x4*)(lds + G_QA + (v >> 5) * 528 + (v & 31) * 16) = pq[it];
                *(u32x4*)(lds + G_KBT + (v >> 3) * 144 + (v & 7) * 16) = pk[it]; }
            *(u32x4*)(lds + G_SC + (tc >> 3) * 144 + (tc & 7) * 16) = ps;
            if (tc < 64) *(u32x4*)(lds + G_ER + tc * 16) = pe;
            const int ep = tc & 63, q8 = tc >> 6;
#define LO2(x, y) (((x) & 0xffffu) | ((y) << 16))
#define HI2(x, y) (((x) >> 16) | ((y) & 0xffff0000u))
            u32x4 v0, v1;
            v0.x = LO2(rv[0], rv[1]); v0.y = LO2(rv[2], rv[3]); v0.z = LO2(rv[4], rv[5]); v0.w = LO2(rv[6], rv[7]);
            v1.x = HI2(rv[0], rv[1]); v1.y = HI2(rv[2], rv[3]); v1.z = HI2(rv[4], rv[5]); v1.w = HI2(rv[6], rv[7]);
            *(u32x4*)(lds + G_VT + (2 * ep) * 144 + q8 * 16) = v0; *(u32x4*)(lds + G_VT + (2 * ep + 1) * 144 + q8 * 16) = v1;
#undef LO2
#undef HI2
        }
        LBAR();
        { const int nn = (n + 1 < 32) ? n + 1 : 31; GS_LOAD(nn, oz); }
        __builtin_amdgcn_sched_barrier(0);
        const int ln = OPQ(c.lane); const int m16 = ln & 15, g4 = ln >> 4;
        const int bA = (int)(uintptr_t)(lds + G_QA) + m16 * 528 + g4 * 8;
        const int bSC = (int)(uintptr_t)(lds + G_SC) + m16 * 144 + g4 * 16;
        const int bKT = (int)(uintptr_t)(lds + G_KBT) + m16 * 144 + g4 * 16;
        const int bF = (int)(uintptr_t)(lds + G_ER) + g4 * 16;
        const int bVT = (int)(uintptr_t)(lds + G_VT) + (16 * w + m16) * 144 + g4 * 16;
        f32x4 o[4];
#pragma unroll
        for (int ti = 0; ti < 4; ++ti) o[ti] = (f32x4){0.f, 0.f, 0.f, 0.f};
#define Q6(ks) do { \
        const u32x2 l0 = lds_rd64<0 * 8448 + (ks) * 64>(bA), h0 = lds_rd64<0 * 8448 + (ks) * 64 + 32>(bA), l1 = lds_rd64<1 * 8448 + (ks) * 64>(bA), h1 = lds_rd64<1 * 8448 + (ks) * 64 + 32>(bA); \
        const u32x2 l2 = lds_rd64<2 * 8448 + (ks) * 64>(bA), h2 = lds_rd64<2 * 8448 + (ks) * 64 + 32>(bA), l3 = lds_rd64<3 * 8448 + (ks) * 64>(bA), h3 = lds_rd64<3 * 8448 + (ks) * 64 + 32>(bA); \
        const u32x2 m0 = lds_rd64<0 * 8448 + (ks) * 64 + 64>(bA), n0 = lds_rd64<0 * 8448 + (ks) * 64 + 96>(bA), m1 = lds_rd64<1 * 8448 + (ks) * 64 + 64>(bA), n1 = lds_rd64<1 * 8448 + (ks) * 64 + 96>(bA); \
        const u32x2 m2 = lds_rd64<2 * 8448 + (ks) * 64 + 64>(bA), n2 = lds_rd64<2 * 8448 + (ks) * 64 + 96>(bA), m3 = lds_rd64<3 * 8448 + (ks) * 64 + 64>(bA), n3 = lds_rd64<3 * 8448 + (ks) * 64 + 96>(bA); \
        u32x4 bw0, bw1; bw0.x = cvt_pk_bf16(S[2 * (ks)][0], S[2 * (ks)][1]); bw0.y = cvt_pk_bf16(S[2 * (ks)][2], S[2 * (ks)][3]); \
        bw0.z = cvt_pk_bf16(S[2 * (ks) + 1][0], S[2 * (ks) + 1][1]); bw0.w = cvt_pk_bf16(S[2 * (ks) + 1][2], S[2 * (ks) + 1][3]); \
        bw1.x = cvt_pk_bf16(S[2 * (ks) + 2][0], S[2 * (ks) + 2][1]); bw1.y = cvt_pk_bf16(S[2 * (ks) + 2][2], S[2 * (ks) + 2][3]); \
        bw1.z = cvt_pk_bf16(S[2 * (ks) + 3][0], S[2 * (ks) + 3][1]); bw1.w = cvt_pk_bf16(S[2 * (ks) + 3][2], S[2 * (ks) + 3][3]); \
        LWAIT(); \
        o[0] = __builtin_amdgcn_mfma_f32_16x16x32_bf16(PKA(l0, h0), AS8(bw0), o[0], 0, 0, 0); o[1] = __builtin_amdgcn_mfma_f32_16x16x32_bf16(PKA(l1, h1), AS8(bw0), o[1], 0, 0, 0); \
        o[2] = __builtin_amdgcn_mfma_f32_16x16x32_bf16(PKA(l2, h2), AS8(bw0), o[2], 0, 0, 0); o[3] = __builtin_amdgcn_mfma_f32_16x16x32_bf16(PKA(l3, h3), AS8(bw0), o[3], 0, 0, 0); \
        o[0] = __builtin_amdgcn_mfma_f32_16x16x32_bf16(PKA(m0, n0), AS8(bw1), o[0], 0, 0, 0); o[1] = __builtin_amdgcn_mfma_f32_16x16x32_bf16(PKA(m1, n1), AS8(bw1), o[1], 0, 0, 0); \
        o[2] = __builtin_amdgcn_mfma_f32_16x16x32_bf16(PKA(m2, n2), AS8(bw1), o[2], 0, 0, 0); o[3] = __builtin_amdgcn_mfma_f32_16x16x32_bf16(PKA(m3, n3), AS8(bw1), o[3], 0, 0, 0); } while (0)
        Q6(0); Q6(2); Q6(4); Q6(6);
#undef Q6
        {
            const u32x4 vb0 = lds_rd128<0>(bVT), vb1 = lds_rd128<64>(bVT);
            const u32x4 s00 = lds_rd128<0 * 2304>(bSC), s01 = lds_rd128<0 * 2304 + 64>(bSC), s10 = lds_rd128<1 * 2304>(bSC), s11 = lds_rd128<1 * 2304 + 64>(bSC);
            const u32x4 s20 = lds_rd128<2 * 2304>(bSC), s21 = lds_rd128<2 * 2304 + 64>(bSC), s30 = lds_rd128<3 * 2304>(bSC), s31 = lds_rd128<3 * 2304 + 64>(bSC);
            LWAIT();
            o[0] = __builtin_amdgcn_mfma_f32_16x16x32_bf16(AS8(s00), AS8(vb0), o[0], 0, 0, 0); o[1] = __builtin_amdgcn_mfma_f32_16x16x32_bf16(AS8(s10), AS8(vb0), o[1], 0, 0, 0);
            o[2] = __builtin_amdgcn_mfma_f32_16x16x32_bf16(AS8(s20), AS8(vb0), o[2], 0, 0, 0); o[3] = __builtin_amdgcn_mfma_f32_16x16x32_bf16(AS8(s30), AS8(vb0), o[3], 0, 0, 0);
            o[0] = __builtin_amdgcn_mfma_f32_16x16x32_bf16(AS8(s01), AS8(vb1), o[0], 0, 0, 0); o[1] = __builtin_amdgcn_mfma_f32_16x16x32_bf16(AS8(s11), AS8(vb1), o[1], 0, 0, 0);
            o[2] = __builtin_amdgcn_mfma_f32_16x16x32_bf16(AS8(s21), AS8(vb1), o[2], 0, 0, 0); o[3] = __builtin_amdgcn_mfma_f32_16x16x32_bf16(AS8(s31), AS8(vb1), o[3], 0, 0, 0);
#define G8(t0) do { \
            const u32x4 k00 = lds_rd128<((t0) + 0) * 2304>(bKT), k01 = lds_rd128<((t0) + 0) * 2304 + 64>(bKT), k10 = lds_rd128<((t0) + 1) * 2304>(bKT), k11 = lds_rd128<((t0) + 1) * 2304 + 64>(bKT); \
            const u32x4 k20 = lds_rd128<((t0) + 2) * 2304>(bKT), k21 = lds_rd128<((t0) + 2) * 2304 + 64>(bKT), k30 = lds_rd128<((t0) + 3) * 2304>(bKT), k31 = lds_rd128<((t0) + 3) * 2304 + 64>(bKT); \
            const f32x4 c0 = lds_rdf<((t0) + 0) * 64>(bF), c1 = lds_rdf<((t0) + 1) * 64>(bF), c2 = lds_rdf<((t0) + 2) * 64>(bF), c3 = lds_rdf<((t0) + 3) * 64>(bF); \
            LWAIT(); \
            S[(t0) + 0] *= c0; S[(t0) + 1] *= c1; S[(t0) + 2] *= c2; S[(t0) + 3] *= c3; \
            S[(t0) + 0] = __builtin_amdgcn_mfma_f32_16x16x32_bf16(AS8(k00), AS8(vb0), S[(t0) + 0], 0, 0, 0); S[(t0) + 1] = __builtin_amdgcn_mfma_f32_16x16x32_bf16(AS8(k10), AS8(vb0), S[(t0) + 1], 0, 0, 0); \
            S[(t0) + 2] = __builtin_amdgcn_mfma_f32_16x16x32_bf16(AS8(k20), AS8(vb0), S[(t0) + 2], 0, 0, 0); S[(t0) + 3] = __builtin_amdgcn_mfma_f32_16x16x32_bf16(AS8(k30), AS8(vb0), S[(t0) + 3], 0, 0, 0); \
            S[(t0) + 0] = __builtin_amdgcn_mfma_f32_16x16x32_bf16(AS8(k01), AS8(vb1), S[(t0) + 0], 0, 0, 0); S[(t0) + 1] = __builtin_amdgcn_mfma_f32_16x16x32_bf16(AS8(k11), AS8(vb1), S[(t0) + 1], 0, 0, 0); \
            S[(t0) + 2] = __builtin_amdgcn_mfma_f32_16x16x32_bf16(AS8(k21), AS8(vb1), S[(t0) + 2], 0, 0, 0); S[(t0) + 3] = __builtin_amdgcn_mfma_f32_16x16x32_bf16(AS8(k31), AS8(vb1), S[(t0) + 3], 0, 0, 0); \
            } while (0)
            G8(0); G8(4);
#pragma unroll
            for (int ti = 0; ti < 4; ++ti) {
#pragma unroll
                for (int r = 0; r < 4; ++r) {
                    const int i = 16 * ti + 4 * g4 + r;
                    og[(size_t)GROW(n, i) * DM + h * 512 + dvs * 128 + 16 * w + m16] = f2bf(o[ti][r]);
                }
            }
            G8(8); G8(12);
#undef G8
        }
    }
    LBAR();
#undef GS_LOAD
}
#undef GROW
#undef OPQ

constexpr int M_WS = 0, M_SV = 34816, M_MU = 34816 + 65536, M_RS = M_MU + 512;
__device__ __forceinline__ void gmlp_item(const Ctx& c, int l, int b, int n, int g) {
    char* lds = c.lds;
    const bf16_t* P = (const bf16_t*)(c.a.ws + WS_P);
    const float* stats = (const float*)(c.a.ws + WS_ST);
    bf16_t* br0 = (bf16_t*)(c.a.ws + WS_BR);
    int gz = 0; asm volatile("" : "+v"(gz));
    const int tid = c.tid + gz, lane = tid & 63, w = c.wid;
    const int T0 = b * SEQ + n * 128;
    __syncthreads();
    if (tid < 128) {
        const float* sp = stats + (size_t)(T0 + tid) * 64; float s = 0.f, q = 0.f;
#pragma unroll
        for (int x = 0; x < 16; ++x) { const f32x4 t = *(const f32x4*)(sp + 4 * x); s += t[0] + t[2]; q += t[1] + t[3]; }
        const float mu = s * (1.f / 2048.f); const float var = fmaxf(q * (1.f / 2048.f) - mu * mu, 0.f);
        *(float*)(lds + M_MU + tid * 4) = mu; *(float*)(lds + M_RS + tid * 4) = rsqrtf(var + EPS);
    }
    {
        const float* wp = c.a.gws + ((size_t)(l * 8 + g) * 128) * 128;
#pragma unroll
        for (int it = 0; it < 8; ++it) { const int e = (it * NTHR + tid) * 4; const int p = e >> 7, q = e & 127;
            const f32x4 t = *(const f32x4*)(wp + e); u32x2 wv; wv.x = cvt_pk_bf16(t[0], t[1]); wv.y = cvt_pk_bf16(t[2], t[3]);
            *(u32x2*)(lds + M_WS + p * 272 + q * 2) = wv; }
    }
    __syncthreads();
    {
        const int c8 = (tid & 15) * 8;
#pragma unroll
        for (int it = 0; it < 8; ++it) {
            const int q = (tid >> 4) + 32 * (it & 3), ch = it >> 2; const int cabs = g * 256 + ch * 128 + c8;
            const u32x4 raw = __builtin_nontemporal_load((const u32x4*)(P + (size_t)(T0 + q) * LDP + C_AV + cabs));
            const float mu = *(const float*)(lds + M_MU + q * 4), rs = *(const float*)(lds + M_RS + q * 4);
            const f32x4 g0 = *(const f32x4*)(c.a.ln_g + l * 2048 + cabs), g1 = *(const f32x4*)(c.a.ln_g + l * 2048 + cabs + 4);
            const f32x4 b0 = *(const f32x4*)(c.a.ln_b + l * 2048 + cabs), b1 = *(const f32x4*)(c.a.ln_b + l * 2048 + cabs + 4);
            float v[8] = {bflo(raw.x), bfhi(raw.x), bflo(raw.y), bfhi(raw.y), bflo(raw.z), bfhi(raw.z), bflo(raw.w), bfhi(raw.w)};
#pragma unroll
            for (int j = 0; j < 4; ++j) { v[j] = (v[j] - mu) * rs * g0[j] + b0[j]; v[4 + j] = (v[4 + j] - mu) * rs * g1[j] + b1[j]; }
            u32x4 wv; wv.x = cvt_pk_bf16(v[0], v[1]); wv.y = cvt_pk_bf16(v[2], v[3]); wv.z = cvt_pk_bf16(v[4], v[5]); wv.w = cvt_pk_bf16(v[6], v[7]);
            *(u32x4*)(lds + M_SV + (ch * 2 + (q >> 6)) * 16384 + att::v_st(q & 63, c8)) = wv;
        }
    }
    __syncthreads();
    const int pb = w & 3, ch = w >> 2, r32 = lane & 31, hi = lane >> 5;
    f32x16 o[4] = {};
#pragma unroll
    for (int qt = 0; qt < 2; ++qt) {
        bf16x8 pa[4];
#pragma unroll
        for (int ks = 0; ks < 4; ++ks) pa[ks] = *(const bf16x8*)(lds + M_WS + (32 * pb + r32) * 272 + (64 * qt + 16 * ks + 8 * hi) * 2);
        const int vb = (int)(uintptr_t)(lds + M_SV + (ch * 2 + qt) * 16384) + att::v_rd_base(lane);
        att::pv_d0(o, vb, pa[0], pa[1], pa[2], pa[3]);
    }
    __syncthreads();
    {
        float* slab = (float*)(lds + w * 16896);
#pragma unroll
        for (int r = 0; r < 16; ++r)
#pragma unroll
            for (int d0 = 0; d0 < 4; ++d0) slab[att::crow(r, hi) * 132 + 32 * d0 + r32] = o[d0][r];
#pragma unroll
        for (int it = 0; it < 8; ++it) {
            const int row = it * 4 + (lane >> 4), c8 = (lane & 15) * 8;
            const int p = 32 * pb + row; const size_t tok = (size_t)(T0 + p); const int cabs = g * 256 + ch * 128 + c8;
            const f32x4 x0 = *(const f32x4*)(slab + row * 132 + c8), x1 = *(const f32x4*)(slab + row * 132 + c8 + 4);
            const u32x4 ur = __builtin_nontemporal_load((const u32x4*)(P + tok * LDP + C_AU + cabs)), zr = __builtin_nontemporal_load((const u32x4*)(P + tok * LDP + C_AZ + cabs));
            const float bsv = c.a.gbs[(size_t)(l * 8 + g) * 128 + p];
            float v[8];
            v[0] = (x0[0] + bsv) * bflo(ur.x) * bflo(zr.x); v[1] = (x0[1] + bsv) * bfhi(ur.x) * bfhi(zr.x);
            v[2] = (x0[2] + bsv) * bflo(ur.y) * bflo(zr.y); v[3] = (x0[3] + bsv) * bfhi(ur.y) * bfhi(zr.y);
            v[4] = (x1[0] + bsv) * bflo(ur.z) * bflo(zr.z); v[5] = (x1[1] + bsv) * bfhi(ur.z) * bfhi(zr.z);
            v[6] = (x1[2] + bsv) * bflo(ur.w) * bflo(zr.w); v[7] = (x1[3] + bsv) * bfhi(ur.w) * bfhi(zr.w);
            u32x4 wv; wv.x = cvt_pk_bf16(v[0], v[1]); wv.y = cvt_pk_bf16(v[2], v[3]); wv.z = cvt_pk_bf16(v[4], v[5]); wv.w = cvt_pk_bf16(v[6], v[7]);
            __builtin_nontemporal_store(wv, (u32x4*)(br0 + tok * DM + cabs));
        }
    }
}

__device__ __forceinline__ void combine_phase(const Ctx& c, int l) {
    const bf16_t* P = (const bf16_t*)(c.a.ws + WS_P);
    const bf16_t* og = (const bf16_t*)(c.a.ws + WS_OG); const bf16_t* oa = (const bf16_t*)(c.a.ws + WS_OA);
    bf16_t* br1 = (bf16_t*)(c.a.ws + WS_BR) + (size_t)MT * DM; bf16_t* br2 = br1 + (size_t)MT * DM;
    const int lane = c.lane;
    const float* lv = c.a.dlam + l * 512;
    float s01 = lv[lane] * lv[128 + lane] + lv[64 + lane] * lv[192 + lane];
    float s23 = lv[256 + lane] * lv[384 + lane] + lv[320 + lane] * lv[448 + lane];
    s01 = wave_sum(s01); s23 = wave_sum(s23);
    const float lam_init = 0.8f - 0.6f * expf(-0.3f * (float)l);
    const float lam = expf(s01) - expf(s23) + lam_init;
    const float oml = 1.f - lam_init;
    const f32x4 gn0 = *(const f32x4*)(c.a.gla_norm + l * 512 + lane * 8), gn1 = *(const f32x4*)(c.a.gla_norm + l * 512 + lane * 8 + 4);
    const f32x4 dn0 = *(const f32x4*)(c.a.dnorm + l * 256 + (lane & 31) * 8), dn1 = *(const f32x4*)(c.a.dnorm + l * 256 + (lane & 31) * 8 + 4);
    const int nw = c.G * 8;
    for (int task = c.bx * 8 + c.wid; task < MT * 8; task += nw) {
        const int tok = task >> 3, sub = task & 7; const int col = (sub & 3) * 512 + lane * 8;
        if (sub < 4) {
            const u32x4 a = __builtin_nontemporal_load((const u32x4*)(og + (size_t)tok * DM + col)), bq = __builtin_nontemporal_load((const u32x4*)(og + (size_t)(MT + tok) * DM + col));
            const u32x4 zr = __builtin_nontemporal_load((const u32x4*)(P + (size_t)tok * LDP + C_BZ + col));
            float v[8] = {bflo(a.x) + bflo(bq.x), bfhi(a.x) + bfhi(bq.x), bflo(a.y) + bflo(bq.y), bfhi(a.y) + bfhi(bq.y),
                          bflo(a.z) + bflo(bq.z), bfhi(a.z) + bfhi(bq.z), bflo(a.w) + bflo(bq.w), bfhi(a.w) + bfhi(bq.w)};
            float ss = 0.f;
#pragma unroll
            for (int j = 0; j < 8; ++j) ss += v[j] * v[j];
            ss = wave_sum(ss); const float ri = rsqrtf(ss * (1.f / 512.f) + EPS);
            const float z[8] = {bflo(zr.x), bfhi(zr.x), bflo(zr.y), bfhi(zr.y), bflo(zr.z), bfhi(zr.z), bflo(zr.w), bfhi(zr.w)};
#pragma unroll
            for (int j = 0; j < 4; ++j) { v[j] = v[j] * ri * gn0[j] * z[j]; v[4 + j] = v[4 + j] * ri * gn1[j] * z[4 + j]; }
            u32x4 wv; wv.x = cvt_pk_bf16(v[0], v[1]); wv.y = cvt_pk_bf16(v[2], v[3]); wv.z = cvt_pk_bf16(v[4], v[5]); wv.w = cvt_pk_bf16(v[6], v[7]);
            __builtin_nontemporal_store(wv, (u32x4*)(br1 + (size_t)tok * DM + col));
        } else {
            const u32x4 a = __builtin_nontemporal_load((const u32x4*)(oa + (size_t)tok * DM + col)), bq = __builtin_nontemporal_load((const u32x4*)(oa + (size_t)(MT + tok) * DM + col));
            const u32x4 zr = __builtin_nontemporal_load((const u32x4*)(P + (size_t)tok * LDP + C_CZ + col));
            float v[8] = {bflo(a.x) - lam * bflo(bq.x), bfhi(a.x) - lam * bfhi(bq.x), bflo(a.y) - lam * bflo(bq.y), bfhi(a.y) - lam * bfhi(bq.y),
                          bflo(a.z) - lam * bflo(bq.z), bfhi(a.z) - lam * bfhi(bq.z), bflo(a.w) - lam * bflo(bq.w), bfhi(a.w) - lam * bfhi(bq.w)};
            float ss = 0.f;
#pragma unroll
            for (int j = 0; j < 8; ++j) ss += v[j] * v[j];
#pragma unroll
            for (int o = 16; o >= 1; o >>= 1) ss += __shfl_xor(ss, o);
            const float ri = rsqrtf(ss * (1.f / 256.f) + EPS) * oml;
            const float z[8] = {bflo(zr.x), bfhi(zr.x), bflo(zr.y), bfhi(zr.y), bflo(zr.z), bfhi(zr.z), bflo(zr.w), bfhi(zr.w)};
#pragma unroll
            for (int j = 0; j < 4; ++j) { v[j] = v[j] * ri * dn0[j] * z[j]; v[4 + j] = v[4 + j] * ri * dn1[j] * z[4 + j]; }
            u32x4 wv; wv.x = cvt_pk_bf16(v[0], v[1]); wv.y = cvt_pk_bf16(v[2], v[3]); wv.z = cvt_pk_bf16(v[4], v[5]); wv.w = cvt_pk_bf16(v[6], v[7]);
            __builtin_nontemporal_store(wv, (u32x4*)(br2 + (size_t)tok * DM + col));
        }
    }
}


#define XB_TMO      128
#define XB_XCNT(j)  (256  + 64 * (j))
#define XB_XSUB(j)  (1280 + 64 * (j))
#define XB_XGEN(j)  (2304 + 64 * (j))
#define XB_TOP      3328
#define XB_TOPGEN   3392
#define XCD_BAR_WORDS 3456
#define XB_SPIN_CAP (1u << 18)
__device__ __forceinline__ unsigned xb_ld(unsigned* p)              { return __hip_atomic_load(p, __ATOMIC_RELAXED, __HIP_MEMORY_SCOPE_AGENT); }
__device__ __forceinline__ unsigned xb_add(unsigned* p, unsigned v) { return __hip_atomic_fetch_add(p, v, __ATOMIC_RELAXED, __HIP_MEMORY_SCOPE_AGENT); }
__device__ __forceinline__ unsigned xb_xcc_id() { return (unsigned)__builtin_amdgcn_s_getreg((3 << 11) | 20) & 0xFu; }
#define XB_SPIN(cond, bar) do { unsigned _sp = 0; while (cond) { __builtin_amdgcn_s_sleep(1); \
    if ((++_sp & 255u) == 0u) { if (xb_ld(&(bar)[XB_TMO])) break; if (_sp > XB_SPIN_CAP) { atomicAdd(&(bar)[XB_TMO], 1u); break; } } } } while (0)
struct XcdBarrier { unsigned* bar; unsigned x; volatile LAS unsigned* st; };
__device__ __forceinline__ void xcd_barrier_complete(unsigned* bar, unsigned x, unsigned& nloc, unsigned& nx) {
    const unsigned G = gridDim.x * gridDim.y * gridDim.z;
    unsigned sum, cnt, mine, sp = 0u;
    for (;;) {
        sum = 0u; cnt = 0u; mine = 0u;
#pragma unroll
        for (unsigned j = 0; j < 16; ++j) { const unsigned c = xb_ld(&bar[XB_XCNT(j)]); sum += c; cnt += (c > 0u) ? 1u : 0u; mine = (j == x) ? c : mine; }
        if (sum == G) break;
        __builtin_amdgcn_s_sleep(1);
        if ((++sp & 255u) == 0u) { if (xb_ld(&bar[XB_TMO])) break; if (sp > XB_SPIN_CAP) { atomicAdd(&bar[XB_TMO], 1u); break; } }
    }
    nloc = mine > 0u ? mine : 1u; nx = cnt > 0u ? cnt : 1u;
}
__device__ __forceinline__ void xcd_barrier(const XcdBarrier& b, const bool t0) {
    asm volatile("s_waitcnt vmcnt(0)" ::: "memory");
    __syncthreads();
    if (t0) {
        unsigned* bar = b.bar;
        __builtin_amdgcn_s_waitcnt(0);
        unsigned nloc = b.st[0], nx = b.st[1];
        if (nloc == 0u) { xcd_barrier_complete(bar, b.x, nloc, nx); b.st[0] = nloc; b.st[1] = nx; }
        const unsigned old = xb_add(&bar[XB_XSUB(b.x)], 1u);
        const unsigned gen = old / nloc;
        if (old + 1u == (gen + 1u) * nloc) {
            __builtin_amdgcn_fence(__ATOMIC_RELEASE, "agent");
            asm volatile("s_waitcnt vmcnt(0)" ::: "memory");
            const unsigned og = xb_add(&bar[XB_TOP], 1u);
            const unsigned tg = og / nx;
            if (og + 1u == (tg + 1u) * nx) xb_add(&bar[XB_TOPGEN], 1u);
            else XB_SPIN(xb_ld(&bar[XB_TOPGEN]) == tg, bar);
            __builtin_amdgcn_fence(__ATOMIC_ACQUIRE, "agent");
            xb_add(&bar[XB_XGEN(b.x)], 1u);
            asm volatile("s_waitcnt vmcnt(0)" ::: "memory");
        } else {
            XB_SPIN(xb_ld(&bar[XB_XGEN(b.x)]) == gen, bar);
            __builtin_amdgcn_fence(__ATOMIC_ACQUIRE, "agent");
            asm volatile("s_waitcnt vmcnt(0)" ::: "memory");
        }
    }
    __syncthreads();
}

__global__ void __launch_bounds__(NTHR, 2) mk_fwd(Args a) {
    extern __shared__ __attribute__((aligned(16))) unsigned char shm[];
    Ctx c; c.a = a; c.lds = (char*)shm;
    const int wid_s = __builtin_amdgcn_readfirstlane((int)threadIdx.x >> 6);
    LAS unsigned char* ldsl = (LAS unsigned char*)shm;
    XcdBarrier xb;
    { volatile LAS unsigned* st = (volatile LAS unsigned*)(ldsl + 147456);
      const bool t0 = (wid_s == 0) && (__builtin_amdgcn_mbcnt_hi(~0u, __builtin_amdgcn_mbcnt_lo(~0u, 0u)) == 0u);
      if (t0) { st[0] = 0u; st[1] = 0u; }
      __syncthreads();
      xb.bar = (unsigned*)(a.ws + WS_BAR); xb.x = xb_xcc_id(); xb.st = st;
      if (t0) st[2] = xb_add(&xb.bar[XB_XCNT(xb.x)], 1u); }
    int vcu_x = -1;
    for (int ph = a.ph_lo; ph < a.ph_hi; ++ph) {
        if (ph > a.ph_lo) {
            if (ph == a.ph_lo + 1) {
                if (a.ph_hi > 1000) cg::this_grid().sync();
                xcd_barrier(xb, (wid_s == 0) && (__builtin_amdgcn_mbcnt_hi(~0u, __builtin_amdgcn_mbcnt_lo(~0u, 0u)) == 0u));
                volatile LAS unsigned* st = (volatile LAS unsigned*)(ldsl + 147456);
                if ((wid_s == 0) && (__builtin_amdgcn_mbcnt_hi(~0u, __builtin_amdgcn_mbcnt_lo(~0u, 0u)) == 0u)) {
                    unsigned pre = 0u, tot = 0u;
#pragma unroll
                    for (unsigned jx = 0; jx < 16; ++jx) { const unsigned cn = xb_ld(&xb.bar[XB_XCNT(jx)]); pre += (jx < xb.x) ? cn : 0u; tot += cn; }
                    st[3] = (tot == gridDim.x) ? pre + st[2] : blockIdx.x;
                }
                __syncthreads();
                vcu_x = __builtin_amdgcn_readfirstlane((int)st[3]);
            }
            else xcd_barrier(xb, (wid_s == 0) && (__builtin_amdgcn_mbcnt_hi(~0u, __builtin_amdgcn_mbcnt_lo(~0u, 0u)) == 0u));
        }
        { int vz = 0, sz = 0; asm volatile("" : "+v"(vz)); asm volatile("" : "+s"(sz));
          c.tid = wid_s * 64 + (int)__builtin_amdgcn_mbcnt_hi(~0u, __builtin_amdgcn_mbcnt_lo(~0u, 0u)) + vz; c.lane = c.tid & 63; c.wid = __builtin_amdgcn_readfirstlane(c.tid >> 6);
          { typedef __attribute__((address_space(1))) unsigned char gu8; gu8* wsp = (gu8*)a.ws; asm volatile("" : "+s"(wsp)); c.a.ws = (unsigned char*)wsp; }
          c.G = gridDim.x; c.bx = (int)blockIdx.x + sz; c.vcu = (vcu_x >= 0) ? vcu_x + sz : ((c.G % 8 == 0) ? (c.bx % 8) * (c.G / 8) + c.bx / 8 : c.bx); }
        unsigned char* const ws = c.a.ws;
        const int l = ph / 7, sp = ph % 7;
        if (ph == 14) { row_pass(c, 2, nullptr, a.norm_post + DM); continue; }
        if (sp == 0) {
            if (l == 0) { if (c.bx == 0) bias_table(c); row_pass(c, 0, a.norm_pre, nullptr); }
            else row_pass(c, 1, a.norm_pre + DM, a.norm_post);
            wconv_job(c, a.w_in + (size_t)l * 2048 * 20512, 20512, (bf16_t*)(ws + WS_W), N1, 1, 1);
        } else if (sp == 1) {
            pg8::Gemm g{(const bf16_t*)(ws + WS_H), (const bf16_t*)(ws + WS_W), MT, NP, DM};
            pg8::StaticOrder S; S.init(MT, NP, c.G, c.bx);
            pg8::Epi1 E{(bf16_t*)(ws + WS_P), (float*)(ws + WS_LR), (float*)(ws + WS_ST)};
#ifndef NO_G1
            pg8::gemm_phase<pg8::Epi1>(ldsl, g, S, E, c.tid);
#endif
        } else if (sp == 2) {
            int nq = 0;
            for (int q = 0; ; ++q) {
                const int item = c.vcu + (q >> 3) * c.G; if (item >= 256) break;
                const int b = item >> 5, nb = item & 31, hd = q & 7;
                if (hd == 0) gla_lr_block(c, b, nb);
                gla_pre_item(c, l, b, hd >> 1, hd & 1, (hd & 1) ? 31 - nb : nb);
                { const int u = c.vcu + q * c.G; if (u < 1792) wconv_super(c, l, u); nq = q + 1; }
            }
            for (int k = nq; c.vcu + k * c.G < 1792; ++k) wconv_super(c, l, c.vcu + k * c.G);
        } else if (sp == 3) {
#ifndef NO_GLA
            for (int it = c.vcu; it < 256; it += c.G) gla_scan_item(c, l, it >> 5, (it >> 3) & 3, (it >> 2) & 1, it & 3);
#endif
#ifndef NO_ATT
            for (int it = c.vcu; it < 2048; it += c.G) attn2_item(c, it >> 8, (it >> 5) & 7, (it >> 4) & 1, it & 15);
#endif
#ifndef NO_GMLP
            for (int it = c.vcu; it < 1024; it += c.G) gmlp_item(c, l, it >> 7, (it >> 3) & 15, it & 7);
#endif
        } else if (sp == 4) {
            combine_phase(c, l);
        } else if (sp == 5) {
            pg8::StaticOrder S; S.init(MT, DM, c.G, c.bx);
            for (int i = 0; i < 3; ++i) {
                { pg8::Gemm g{(const bf16_t*)(ws + WS_H), (const bf16_t*)(ws + WS_WM) + (size_t)i * 2048 * 2048, MT, DM, DM};
                  pg8::EpiGate E{(bf16_t*)(ws + WS_GATE) + (size_t)i * MT * DM, a.b_merge + l * 6144 + i * 2048};
#ifndef NO_G4A
                  pg8::gemm_phase<pg8::EpiGate>(ldsl, g, S, E, c.tid);
#endif
 }
                { pg8::Gemm g{(const bf16_t*)(ws + WS_BR) + (size_t)i * MT * DM, (const bf16_t*)(ws + WS_WB) + (size_t)i * 2048 * 2048, MT, DM, DM};
                  pg8::EpiBranch E{(const bf16_t*)(ws + WS_GATE) + (size_t)i * MT * DM, (const bf16_t*)(ws + WS_MF) + (size_t)(i > 0 ? i - 1 : 0) * MT * DM, (i < 2) ? (bf16_t*)(ws + WS_MF) + (size_t)i * MT * DM : (bf16_t*)(ws + WS_MB), i};
#ifndef NO_G4B
                  pg8::gemm_phase<pg8::EpiBranch>(ldsl, g, S, E, c.tid);
#endif
 }
            }
        } else {
            pg8::Gemm g{(const bf16_t*)(ws + WS_MB), (const bf16_t*)(ws + WS_WO), MT, DM, DM};
            pg8::StaticOrder S; S.init(MT, DM, c.G, c.bx);
            pg8::EpiBf16Out E{(bf16_t*)(ws + WS_OUTF), DM};
#ifndef NO_G5
            pg8::gemm_phase<pg8::EpiBf16Out>(ldsl, g, S, E, c.tid);
#endif
        }
    }
}


#ifdef TESTK
__global__ void __launch_bounds__(NTHR, 2) tk(const bf16_t* A, const bf16_t* Bt, float* C) {
    extern __shared__ __attribute__((aligned(16))) unsigned char shm[];
    pg8::Gemm g{A, Bt, MT, DM, DM};
    pg8::StaticOrder S; S.init(MT, DM, gridDim.x, blockIdx.x);
    pg8::EpiF32 E{C, DM};
    pg8::gemm_phase<pg8::EpiF32>((LAS unsigned char*)shm, g, S, E, threadIdx.x);
}
#endif
extern "C" void kernel_launch(void* const* d_in, const int* in_sizes, int n_in, void* d_out, int out_size, void* d_ws, size_t ws_size, hipStream_t stream) {
    static int grid = 0;
    if (grid == 0) {
        if (n_in != 18 || out_size != MT * DM || ws_size < WS_END) { fprintf(stderr, "kernel_launch: unexpected shapes (n_in %d out %d ws %zu need %zu)\n", n_in, out_size, ws_size, (size_t)WS_END); grid = -1; return; }
        if (hipFuncSetAttribute((const void*)mk_fwd, hipFuncAttributeMaxDynamicSharedMemorySize, LDS_BYTES) != hipSuccess) { fprintf(stderr, "kernel_launch: hipFuncSetAttribute failed\n"); grid = -1; return; }
        int dev = 0, cus = 0, per_cu = 0;
        hipGetDevice(&dev); hipDeviceGetAttribute(&cus, hipDeviceAttributeMultiprocessorCount, dev);
        hipOccupancyMaxActiveBlocksPerMultiprocessor(&per_cu, (const void*)mk_fwd, NTHR, LDS_BYTES);
        (void)hipGetLastError();
        if (per_cu < 1) per_cu = 1;
        grid = cus;
    }
    if (grid < 0) return;
    (void)hipMemsetAsync((char*)d_ws + WS_BAR, 0, 16384, stream);
    Args a{};
    a.x = (const float*)d_in[0]; a.norm_pre = (const float*)d_in[1]; a.w_in = (const float*)d_in[2]; a.ln_g = (const float*)d_in[3]; a.ln_b = (const float*)d_in[4];
    a.gws = (const float*)d_in[5]; a.gbs = (const float*)d_in[6]; a.wa2 = (const float*)d_in[7]; a.ba = (const float*)d_in[8]; a.gla_norm = (const float*)d_in[9];
    a.dlam = (const float*)d_in[10]; a.dnorm = (const float*)d_in[11]; a.rel_bias = (const float*)d_in[12]; a.w_branch = (const float*)d_in[13]; a.w_merge = (const float*)d_in[14];
    a.b_merge = (const float*)d_in[15]; a.w_out = (const float*)d_in[16]; a.norm_post = (const float*)d_in[17];
    a.out = (float*)d_out; a.ws = (unsigned char*)d_ws;
#if MK_ONE_LAUNCH
    a.ph_lo = 0; a.ph_hi = 15;
    void* args[] = {&a};
    hipError_t e = hipLaunchCooperativeKernel((const void*)mk_fwd, dim3(grid), dim3(NTHR), args, LDS_BYTES, stream);
    if (e != hipSuccess) fprintf(stderr, "cooperative launch failed: %s (grid %d)\n", hipGetErrorString(e), grid);
#else
    for (int ph = 0; ph < 15; ++ph) {
        a.ph_lo = ph; a.ph_hi = ph + 1;
        hipLaunchKernelGGL(mk_fwd, dim3(grid), dim3(NTHR), LDS_BYTES, stream, a);
    }
#endif
}
```
